# Optimizing an MI355X kernel written in HIP

```python
import math
import jax
import jax.numpy as jnp
from jax import lax
import numpy as np

D_MODEL = 4096
BATCH = 1
SEQ = 8192
DEPTH = 1

MIX_W = D_MODEL
HEAD_DIM = 128
ATTN_W = MIX_W // 2
CONV_W = MIX_W - ATTN_W
N_ATTN_HEADS = ATTN_W // HEAD_DIM
N_CONV_GROUPS = CONV_W // HEAD_DIM
BLOCK = 256
TOPK = 3
QCHUNK = 32
CONV_WIDTH = 3
NUM_BUCKETS = 32
MAX_DISTANCE = 128
EPS = 1e-6
PROJ_W = 4 * ATTN_W + 4 * CONV_W

kernel_name = "hymba_moba_shortconv_t5bias"


def rmsnorm(x, g):
    xf = x.astype(jnp.float32)
    y = xf * lax.rsqrt(jnp.mean(xf * xf, axis=-1, keepdims=True) + EPS)
    return (y * g.astype(jnp.float32)).astype(x.dtype)


def rel_bucket(dist):
    n = jnp.maximum(dist, 0)
    max_exact = NUM_BUCKETS // 2
    nf = jnp.maximum(n, 1).astype(jnp.float32)
    large = max_exact + (jnp.log(nf / max_exact) / math.log(MAX_DISTANCE / max_exact)
                         * (NUM_BUCKETS - max_exact)).astype(jnp.int32)
    large = jnp.minimum(large, NUM_BUCKETS - 1)
    return jnp.where(n < max_exact, n, large)


def moba_attention(q, k, v, rel_bias):
    B, S, H, Dh = q.shape
    nb = -(-S // BLOCK)
    s_pad = nb * BLOCK
    pad = ((0, 0), (0, s_pad - S), (0, 0), (0, 0))
    kp = jnp.pad(k, pad)
    vp = jnp.pad(v, pad)
    kb = kp.reshape(B, nb, BLOCK, H, Dh)
    vb = vp.reshape(B, nb, BLOCK, H, Dh)
    kmean = jnp.mean(kb.astype(jnp.float32), axis=2)

    pos = jnp.arange(S)
    qblk = pos // BLOCK
    gate = jnp.einsum('bshd,bnhd->bhsn', q.astype(jnp.float32), kmean)
    past = jnp.arange(nb)[None, :] < qblk[:, None]
    gate = jnp.where(past[None, None], gate, -jnp.inf)
    k_eff = min(TOPK, nb)
    _, sel = lax.top_k(gate, k_eff)
    valid = jnp.arange(k_eff)[None, :] < qblk[:, None]

    kbh = kb.transpose(0, 3, 1, 2, 4)
    vbh = vb.transpose(0, 3, 1, 2, 4)
    bias_tab = rel_bias.T.astype(jnp.float32)
    b_i = jnp.arange(B)[:, None, None, None]
    h_i = jnp.arange(H)[None, :, None, None]
    kin = jnp.arange(BLOCK)
    scale = Dh ** -0.5

    def chunk(c):
        start = c * QCHUNK
        qpos = start + jnp.arange(QCHUNK)
        q_c = lax.dynamic_slice_in_dim(q, start, QCHUNK, 1)
        sel_c = lax.dynamic_slice_in_dim(sel, start, QCHUNK, 2)
        val_c = lax.dynamic_slice_in_dim(valid, start, QCHUNK, 0)
        k_sel = kbh[b_i, h_i, sel_c]
        v_sel = vbh[b_i, h_i, sel_c]
        kpos = sel_c[..., None] * BLOCK + kin
        dist = qpos[None, None, :, None, None] - kpos
        bias_s = bias_tab[h_i[..., None], rel_bucket(dist)]
        l_sel = jnp.einsum('bqhd,bhqnkd->bhqnk', q_c, k_sel).astype(jnp.float32) * scale + bias_s
        l_sel = jnp.where(val_c[None, None, :, :, None], l_sel, -jnp.inf)
        own = start // BLOCK
        k_own = lax.dynamic_slice_in_dim(kp, own * BLOCK, BLOCK, 1)
        v_own = lax.dynamic_slice_in_dim(vp, own * BLOCK, BLOCK, 1)
        dist_o = qpos[:, None] - (own * BLOCK + kin)[None, :]
        bias_o = bias_tab[:, rel_bucket(dist_o)]
        l_own = jnp.einsum('bqhd,bkhd->bhqk', q_c, k_own).astype(jnp.float32) * scale + bias_o[None]
        l_own = jnp.where((dist_o >= 0)[None, None], l_own, -jnp.inf)
        logits = jnp.concatenate([l_sel.reshape(B, H, QCHUNK, k_eff * BLOCK), l_own], axis=-1)
        p = jax.nn.softmax(logits, axis=-1).astype(v.dtype)
        p_sel = p[..., :k_eff * BLOCK].reshape(B, H, QCHUNK, k_eff, BLOCK)
        p_own = p[..., k_eff * BLOCK:]
        return (jnp.einsum('bhqnk,bhqnkd->bqhd', p_sel, v_sel)
                + jnp.einsum('bhqk,bkhd->bqhd', p_own, v_own))

    out = lax.map(chunk, jnp.arange(S // QCHUNK))
    return jnp.moveaxis(out, 0, 1).reshape(B, S, H, Dh)


def short_conv(u, w):
    S = u.shape[1]
    up = jnp.pad(u, ((0, 0), (CONV_WIDTH - 1, 0), (0, 0)))
    y = up[:, 0:S] * w[0]
    for j in range(1, CONV_WIDTH):
        y = y + up[:, j:j + S] * w[j]
    return y


def setup_inputs(seed: int = 0) -> dict:
    key = jax.random.key(seed)
    ks = jax.random.split(key, 8)
    x = jax.random.normal(ks[0], (BATCH, SEQ, D_MODEL), jnp.float32)
    norm_gain = 1.0 + 0.02 * jax.random.normal(ks[1], (DEPTH, D_MODEL), jnp.float32)
    w_in = jax.random.normal(ks[2], (DEPTH, D_MODEL, PROJ_W), jnp.float32) * D_MODEL ** -0.5
    conv_w = jax.random.normal(ks[3], (DEPTH, CONV_WIDTH, CONV_W), jnp.float32) * CONV_WIDTH ** -0.5
    w_out = jax.random.normal(ks[4], (DEPTH, ATTN_W + CONV_W, D_MODEL), jnp.float32) * (ATTN_W + CONV_W) ** -0.5
    rel_bias = 0.5 * jax.random.normal(ks[5], (NUM_BUCKETS, N_ATTN_HEADS), jnp.float32)
    final_gain = 1.0 + 0.02 * jax.random.normal(ks[6], (D_MODEL,), jnp.float32)
    return {"x": x, "norm_gain": norm_gain, "w_in": w_in, "conv_w": conv_w,
            "w_out": w_out, "rel_bias": rel_bias, "final_gain": final_gain}


def reference(x, norm_gain, w_in, conv_w, w_out, rel_bias, final_gain):
    B, S, _ = x.shape
    split_at = [ATTN_W, 2 * ATTN_W, 3 * ATTN_W, 4 * ATTN_W,
                4 * ATTN_W + CONV_W, 4 * ATTN_W + 2 * CONV_W, 4 * ATTN_W + 3 * CONV_W]
    h = x
    for l in range(DEPTH):
        u = rmsnorm(h, norm_gain[l])
        proj = jnp.einsum('bsd,df->bsf', u, w_in[l])
        q, k, v, z_a, hc, b_gate, c_gate, z_c = jnp.split(proj, split_at, axis=-1)
        q = q.reshape(B, S, N_ATTN_HEADS, HEAD_DIM)
        k = k.reshape(B, S, N_ATTN_HEADS, HEAD_DIM)
        v = v.reshape(B, S, N_ATTN_HEADS, HEAD_DIM)
        attn = moba_attention(q, k, v, rel_bias).reshape(B, S, ATTN_W) * jax.nn.silu(z_a)
        conv = b_gate * short_conv(c_gate * hc, conv_w[l]) * jax.nn.silu(z_c)
        mixed = jnp.concatenate([attn, conv], axis=-1)
        h = h + jnp.einsum('bsf,fd->bsd', mixed, w_out[l])
    return rmsnorm(h, final_gain)
```

```cpp
#include <hip/hip_runtime.h>
#include <cstdio>
#include <cstdint>
#include <cmath>

#ifndef MK_N_LAUNCHES
#define MK_N_LAUNCHES 1
#endif

#define LAS __attribute__((address_space(3)))
#define GAS __attribute__((address_space(1)))
typedef unsigned short bf16_t;
typedef short bf16x8 __attribute__((ext_vector_type(8)));
typedef short s16x4 __attribute__((ext_vector_type(4)));
typedef float f32x4 __attribute__((ext_vector_type(4)));
typedef float f32x16 __attribute__((ext_vector_type(16)));
typedef unsigned u32x4 __attribute__((ext_vector_type(4)));
typedef unsigned u32x2 __attribute__((ext_vector_type(2)));
typedef float f32x2_t __attribute__((ext_vector_type(2)));
typedef __bf16 bf16x2_t __attribute__((ext_vector_type(2)));

constexpr int SEQ = 8192, DM = 4096, PW = 16384, AW = 2048, NH = 16, HD = 128, BLK = 256, NB = 32;
constexpr int COL_Q = 0, COL_K = 2048, COL_V = 4096, COL_ZA = 6144, COL_HC = 8192, COL_BG = 10240, COL_CG = 12288, COL_ZC = 14336;
constexpr float EPS = 1e-6f;
constexpr float LOG2E = 1.4426950408889634f;
constexpr float QK_C = 0.08838834764831845f * LOG2E;

__device__ __forceinline__ unsigned cvtpk(float lo, float hi) { f32x2_t v = {lo, hi}; bf16x2_t b = __builtin_convertvector(v, bf16x2_t); return __builtin_bit_cast(unsigned, b); }
__device__ __forceinline__ float bf_lo(unsigned w) { return __uint_as_float(w << 16); }
__device__ __forceinline__ float bf_hi(unsigned w) { return __uint_as_float(w & 0xffff0000u); }
__device__ __forceinline__ float silu_f(float z) { return z / (1.f + __expf(-z)); }
__device__ __forceinline__ int crow(int r, int hi) { return (r & 3) + 8 * (r >> 2) + 4 * hi; }

namespace pg8 {
#define PG8_LAS __attribute__((address_space(3)))
constexpr int BM = 256, BK = 64, HALF = 128, HTB = HALF * BK * 2, STAGE_BYTES = 8 * HTB, NXCD = 8, WGM = 8;
__host__ __device__ __forceinline__ int lds_byte(int r, int c) { const int st = (r >> 4) * 2 + (c >> 5), rr = r & 15, cc = c & 31, ob = rr * 64 + cc * 2; return st * 1024 + (ob ^ (((ob >> 9) & 1) << 5)); }
__host__ __device__ __forceinline__ void stage_rc(int b, int& R, int& C) { const int st = b / 1024, sb = b % 1024, swz = sb ^ (((sb >> 9) & 1) << 5); R = (st >> 1) * 16 + swz / 64; C = (st & 1) * 32 + (swz % 64) / 2; }
__host__ __device__ __forceinline__ int perm32(int rho) { const int n = rho >> 4, i = rho & 15; return 8 * (i >> 2) + 4 * n + (i & 3); }

struct Unit { int pm, pn; };
struct Gemm { const bf16_t* A; const bf16_t* Bt; int M, N, K; };

struct StaticOrder {
    int nM, nN, nwg, G, c;
    __host__ __device__ void init(int M, int N, int G_, int c_) { nM = M / BM; nN = N / BM; nwg = nM * nN; G = G_; c = c_; }
    __host__ __device__ bool next(int i, Unit& u) const {
        const long L = (long)i * G + c; if (L >= nwg) return false;
        int wgid = (int)L; { const int q = nwg / NXCD, r = nwg % NXCD, xcd = wgid % NXCD, off = wgid / NXCD; wgid = (xcd < r ? xcd * (q + 1) : r * (q + 1) + (xcd - r) * q) + off; }
        const int nig = WGM * nN, gid = wgid / nig, fm = gid * WGM, gsz = (nM - fm) < WGM ? (nM - fm) : WGM;
        u.pm = fm + ((wgid % nig) % gsz); u.pn = (wgid % nig) / gsz; return true;
    }
    __device__ __forceinline__ void a_ready(const Unit&) const {}
    __device__ __forceinline__ void done(const Unit&) const {}
};

struct EpiProj {
    static constexpr bool PERM = true, AFTER_DRAIN = false;
    bf16_t* O; int ldc; float* ksum;
    __device__ __forceinline__ void operator()(const f32x4 (&acc)[2][2][4][2], const Unit& u, int wr, int wc, int fr, int fq) const {
        const int row0 = u.pm * BM + wr * 64 + fr; const int col0 = u.pn * BM + wc * 32 + 8 * fq;
#pragma unroll
        for (int ai = 0; ai < 2; ++ai)
#pragma unroll
            for (int m = 0; m < 4; ++m) { bf16_t* rowp = O + (size_t)(row0 + ai * HALF + m * 16) * ldc + col0;
#pragma unroll
                for (int bj = 0; bj < 2; ++bj) { const f32x4 v0 = acc[ai][bj][m][0], v1 = acc[ai][bj][m][1];
                    u32x4 w; w.x = cvtpk(v0[0], v0[1]); w.y = cvtpk(v0[2], v0[3]); w.z = cvtpk(v1[0], v1[1]); w.w = cvtpk(v1[2], v1[3]);
                    *(u32x4*)(rowp + bj * HALF) = w; } }
        if (u.pn >= 8 && u.pn < 16) {
            float* kp = ksum + (size_t)u.pm * 2048 + (u.pn - 8) * BM + wc * 32 + 8 * fq;
#pragma unroll
            for (int bj = 0; bj < 2; ++bj)
#pragma unroll
                for (int n = 0; n < 2; ++n) {
                    f32x4 s = acc[0][bj][0][n];
#pragma unroll
                    for (int m = 1; m < 4; ++m) s += acc[0][bj][m][n];
#pragma unroll
                    for (int m = 0; m < 4; ++m) s += acc[1][bj][m][n];
#pragma unroll
                    for (int j = 0; j < 4; ++j) { float v = s[j]; v += __shfl_xor(v, 1); v += __shfl_xor(v, 2); v += __shfl_xor(v, 4); v += __shfl_xor(v, 8);
                        if (fr == 0) atomicAdd(kp + bj * HALF + 4 * n + j, v); }
                }
        }
    }
};
struct EpiOut {
    static constexpr bool PERM = false, AFTER_DRAIN = false;
    const float* X; float* out; float* rowss;
    __device__ __forceinline__ void operator()(const f32x4 (&acc)[2][2][4][2], const Unit& u, int wr, int wc, int fr, int fq) const {
        const int col0 = u.pn * BM + wc * 32 + 4 * fq;
#pragma unroll
        for (int ai = 0; ai < 2; ++ai)
#pragma unroll
            for (int m = 0; m < 4; ++m) { const int row = u.pm * BM + ai * HALF + wr * 64 + m * 16 + fr; const size_t off = (size_t)row * DM + col0; float ss = 0.f;
#pragma unroll
                for (int bj = 0; bj < 2; ++bj)
#pragma unroll
                    for (int n = 0; n < 2; ++n) { const f32x4 xv = *(const f32x4*)(X + off + bj * HALF + n * 16); const f32x4 hv = xv + acc[ai][bj][m][n];
                        *(f32x4*)(out + off + bj * HALF + n * 16) = hv; ss += (hv[0] * hv[0] + hv[1] * hv[1]) + (hv[2] * hv[2] + hv[3] * hv[3]); }
                ss += __shfl_xor(ss, 16); ss += __shfl_xor(ss, 32);
                if (fq == 0) rowss[(size_t)row * 64 + u.pn * 4 + wc] = ss; }
    }
};

template <class Epi, class Sched, bool ALIGN_EPI = false, bool SP2 = false>
__device__ __forceinline__ void gemm_phase(PG8_LAS unsigned char* lds, const Gemm g, const Sched& S, const Epi& E) {
    const int tid = threadIdx.x, wid = __builtin_amdgcn_readfirstlane(tid >> 6), lane = tid & 63, wr = wid >> 2, wc = wid & 3, fr = lane & 15, fq = lane >> 4;
    const int K = g.K, nt = K / BK;
    unsigned voffA[2], voffB[2];
#pragma unroll
    for (int i = 0; i < 2; ++i) { int R, C; stage_rc(tid * 16 + i * 8192, R, C); const int Rb = Epi::PERM ? ((R & ~31) + perm32(R & 31)) : R;
        voffA[i] = (unsigned)(R * K + C) * 2u; voffB[i] = (unsigned)(Rb * K + C) * 2u; }
    const size_t kstep = (size_t)(BK * 2);
    const size_t hstep = (size_t)HALF * K * 2;
    const size_t tstep = 2 * hstep;
    const unsigned ldsw = (unsigned)wid * 1024u;
    const int aoff = lds_byte(wr * 64 + fr, fq * 8), boff = lds_byte(wc * 32 + fr, fq * 8);
#define PG8_SA(b, h) (((b) * 2 + (h)) * HTB)
#define PG8_SB(b, h) ((4 + (b) * 2 + (h)) * HTB)
#define PG8_STAGE(bufoff, gbase, voff) do { _Pragma("unroll") for (int _i = 0; _i < 2; ++_i) \
        __builtin_amdgcn_global_load_lds((const unsigned*)((const char*)(gbase) + (voff)[_i]), (PG8_LAS unsigned*)(lds + (bufoff) + ldsw + _i * 8192), 16, 0, 0); } while (0)
#define PG8_LDA(dst, b, h) do { _Pragma("unroll") for (int m = 0; m < 4; ++m) _Pragma("unroll") for (int k = 0; k < 2; ++k) dst[m][k] = *(const PG8_LAS bf16x8*)(lds + PG8_SA(b, h) + aoff + m * 2048 + k * 1024); } while (0)
#define PG8_LDB(dst, b, h) do { _Pragma("unroll") for (int n = 0; n < 2; ++n) _Pragma("unroll") for (int k = 0; k < 2; ++k) dst[n][k] = *(const PG8_LAS bf16x8*)(lds + PG8_SB(b, h) + boff + n * 2048 + k * 1024); } while (0)
#define PG8_MMA(ai, bj, At, Bt) do { __builtin_amdgcn_s_setprio(1); _Pragma("unroll") for (int m = 0; m < 4; ++m) _Pragma("unroll") for (int n = 0; n < 2; ++n) _Pragma("unroll") for (int k = 0; k < 2; ++k) \
        acc[ai][bj][m][n] = __builtin_amdgcn_mfma_f32_16x16x32_bf16(Bt[n][k], At[m][k], acc[ai][bj][m][n], 0, 0, 0); __builtin_amdgcn_s_setprio(0); } while (0)
#define PG8_WAIT_V(n) asm volatile("s_waitcnt vmcnt(" #n ")" ::: "memory")
#define PG8_WAIT_L(n) asm volatile("s_waitcnt lgkmcnt(" #n ")" ::: "memory")
#define PG8_BAR __builtin_amdgcn_s_barrier()
#define PG8_SCHED __builtin_amdgcn_sched_barrier(0)
    Unit cur, nxt; int ui = 0;
    if (!S.next(0, cur)) return;
    f32x4 acc[2][2][4][2];
#pragma unroll
    for (int a = 0; a < 2; ++a)
#pragma unroll
        for (int b = 0; b < 2; ++b)
#pragma unroll
            for (int m = 0; m < 4; ++m)
#pragma unroll
                for (int n = 0; n < 2; ++n) acc[a][b][m][n] = (f32x4){0.f, 0.f, 0.f, 0.f};
    bf16x8 At[4][2], B0[2][2], B1[2][2];
    const char* cA = (const char*)g.A + (size_t)cur.pm * tstep; const char* cB = (const char*)g.Bt + (size_t)cur.pn * tstep;
    S.a_ready(cur);
    if constexpr (SP2) {
        PG8_STAGE(PG8_SB(0, 0), cB, voffB); PG8_STAGE(PG8_SB(0, 1), cB + hstep, voffB); PG8_STAGE(PG8_SA(0, 0), cA, voffA); PG8_STAGE(PG8_SA(0, 1), cA + hstep, voffA);
        if (wr == 1) PG8_BAR;
        PG8_WAIT_V(2); PG8_BAR;
        PG8_STAGE(PG8_SB(1, 0), cB + kstep, voffB); PG8_STAGE(PG8_SA(1, 0), cA + kstep, voffA); PG8_STAGE(PG8_SB(1, 1), cB + hstep + kstep, voffB);
        PG8_WAIT_V(6); PG8_BAR;
    } else {
        PG8_STAGE(PG8_SB(0, 0), cB, voffB); PG8_STAGE(PG8_SA(0, 0), cA, voffA); PG8_STAGE(PG8_SB(0, 1), cB + hstep, voffB); PG8_STAGE(PG8_SA(0, 1), cA + hstep, voffA);
        if (wr == 1) PG8_BAR;
        PG8_WAIT_V(4); PG8_BAR;
        PG8_STAGE(PG8_SB(1, 0), cB + kstep, voffB); PG8_STAGE(PG8_SA(1, 0), cA + kstep, voffA); PG8_STAGE(PG8_SB(1, 1), cB + hstep + kstep, voffB);
        PG8_WAIT_V(6); PG8_BAR;
    }
    for (;;) {
        const bool has_next = S.next(ui + 1, nxt);
        const char* nA = has_next ? (const char*)g.A + (size_t)nxt.pm * tstep : cA; const char* nB = has_next ? (const char*)g.Bt + (size_t)nxt.pn * tstep : cB;
        for (int t = 0; t < nt; t += 2) {
            const bool last = (t == nt - 2);
            const char* a1 = cA + (size_t)(t + 1) * kstep;
            const char* a2 = last ? nA : cA + (size_t)(t + 2) * kstep; const char* b2 = last ? nB : cB + (size_t)(t + 2) * kstep;
            const char* a3 = a2 + kstep; const char* b3 = b2 + kstep;
            if (last && has_next) S.a_ready(nxt);
            if constexpr (SP2) {
            PG8_LDB(B0, 0, 0); PG8_LDB(B1, 0, 1); PG8_SCHED; PG8_LDA(At, 0, 0); PG8_STAGE(PG8_SA(1, 1), a1 + hstep, voffA);
            PG8_WAIT_V(8); PG8_WAIT_L(0); PG8_BAR; PG8_MMA(0, 0, At, B0); PG8_MMA(0, 1, At, B1); PG8_BAR; PG8_SCHED;
            PG8_LDA(At, 0, 1); PG8_STAGE(PG8_SB(0, 0), b2, voffB); PG8_STAGE(PG8_SB(0, 1), b2 + hstep, voffB); PG8_STAGE(PG8_SA(0, 0), a2, voffA);
            PG8_WAIT_V(8); PG8_WAIT_L(0); PG8_BAR; PG8_MMA(1, 0, At, B0); PG8_MMA(1, 1, At, B1); PG8_BAR; PG8_SCHED;
            PG8_LDB(B0, 1, 0); PG8_LDB(B1, 1, 1); PG8_SCHED; PG8_LDA(At, 1, 0); PG8_STAGE(PG8_SA(0, 1), a2 + hstep, voffA);
            PG8_WAIT_V(8); PG8_WAIT_L(0); PG8_BAR; PG8_MMA(0, 0, At, B0); PG8_MMA(0, 1, At, B1); PG8_BAR; PG8_SCHED;
            PG8_LDA(At, 1, 1); PG8_STAGE(PG8_SB(1, 0), b3, voffB); PG8_STAGE(PG8_SB(1, 1), b3 + hstep, voffB); PG8_STAGE(PG8_SA(1, 0), a3, voffA);
            PG8_WAIT_V(8); PG8_WAIT_L(0); PG8_BAR; PG8_MMA(1, 0, At, B0); PG8_MMA(1, 1, At, B1); PG8_BAR; PG8_SCHED;
            } else {
            PG8_LDB(B0, 0, 0); PG8_SCHED; PG8_LDA(At, 0, 0); PG8_STAGE(PG8_SA(1, 1), a1 + hstep, voffA);
            PG8_WAIT_L(8); PG8_BAR; PG8_WAIT_L(0); PG8_MMA(0, 0, At, B0); PG8_BAR; PG8_SCHED;
            PG8_LDB(B1, 0, 1); PG8_STAGE(PG8_SB(0, 0), b2, voffB);
            PG8_BAR; PG8_WAIT_L(0); PG8_MMA(0, 1, At, B1); PG8_BAR;
            PG8_LDA(At, 0, 1); PG8_STAGE(PG8_SA(0, 0), a2, voffA);
            PG8_BAR; PG8_WAIT_L(0); PG8_MMA(1, 0, At, B0); PG8_BAR; PG8_SCHED;
            PG8_STAGE(PG8_SB(0, 1), b2 + hstep, voffB);
            PG8_WAIT_V(6); PG8_BAR; PG8_MMA(1, 1, At, B1); PG8_BAR;
            PG8_LDB(B0, 1, 0); PG8_SCHED; PG8_LDA(At, 1, 0); PG8_STAGE(PG8_SA(0, 1), a2 + hstep, voffA);
            PG8_WAIT_L(8); PG8_BAR; PG8_WAIT_L(0); PG8_MMA(0, 0, At, B0); PG8_BAR; PG8_SCHED;
            PG8_LDB(B1, 1, 1); PG8_STAGE(PG8_SB(1, 0), b3, voffB);
            PG8_BAR; PG8_WAIT_L(0); PG8_MMA(0, 1, At, B1); PG8_BAR;
            PG8_LDA(At, 1, 1); PG8_STAGE(PG8_SA(1, 0), a3, voffA);
            PG8_BAR; PG8_WAIT_L(0); PG8_MMA(1, 0, At, B0); PG8_BAR; PG8_SCHED;
            PG8_STAGE(PG8_SB(1, 1), b3 + hstep, voffB);
            PG8_WAIT_V(6); PG8_BAR; PG8_MMA(1, 1, At, B1); PG8_BAR;
            }
        }
        if constexpr (ALIGN_EPI) { if (wr == 0) PG8_BAR; }
        if constexpr (!Epi::AFTER_DRAIN) { E(acc, cur, wr, wc, fr, fq); S.done(cur); }
        if (!has_next) break;
#pragma unroll
        for (int a = 0; a < 2; ++a)
#pragma unroll
            for (int b = 0; b < 2; ++b)
#pragma unroll
                for (int m = 0; m < 4; ++m)
#pragma unroll
                    for (int n = 0; n < 2; ++n) acc[a][b][m][n] = (f32x4){0.f, 0.f, 0.f, 0.f};
        cur = nxt; cA = nA; cB = nB; ++ui;
        if constexpr (ALIGN_EPI) { if (wr == 1) PG8_BAR; }
    }
    PG8_WAIT_V(0);
    if constexpr (!ALIGN_EPI) { if (wr == 0) PG8_BAR; }
    PG8_BAR;
#undef PG8_SA
#undef PG8_SB
#undef PG8_STAGE
#undef PG8_LDA
#undef PG8_LDB
#undef PG8_MMA
#undef PG8_WAIT_V
#undef PG8_WAIT_L
#undef PG8_BAR
#undef PG8_SCHED
}
}

constexpr int NWAVES = 8;
constexpr int N_LAUNCHES = MK_N_LAUNCHES;
constexpr int N_PHASES = 7;

constexpr size_t MiB = 1u << 20;
constexpr size_t WS_CTL = 0, CTL_ZERO_BYTES = 1 * MiB;
constexpr size_t WS_WIN = 2 * MiB;
constexpr size_t WS_WOUT = 130 * MiB;
constexpr size_t WS_U = 162 * MiB;
constexpr size_t WS_PROJ = 226 * MiB;
constexpr size_t WS_MIX = 482 * MiB;
constexpr size_t WS_PART = 546 * MiB;
constexpr size_t WS_LSE = 674 * MiB;
constexpr size_t WS_KSUM = 676 * MiB;
constexpr size_t WS_LIST = 677 * MiB;
constexpr size_t WS_CNT = 685 * MiB;
constexpr size_t WS_ROWSS = 686 * MiB;
constexpr size_t WS_END = 688 * MiB;
constexpr int CW_BAR = 4096;
constexpr int CW_ITEM = 64;

constexpr int RING_BYTES = 131072;
constexpr int LDSCTL_OFF = RING_BYTES, MISC_OFF = LDSCTL_OFF + 320;
constexpr int ATT_LUT_OFF = RING_BYTES + 1024;
constexpr int ATT_MISC_OFF = ATT_LUT_OFF + 3072;
constexpr int LDS_BYTES = 147456;

typedef GAS unsigned gu32;
#define RLX_AGENT __ATOMIC_RELAXED, __HIP_MEMORY_SCOPE_AGENT
#define LDS_WAIT() asm volatile("s_waitcnt lgkmcnt(0)" ::: "memory")
#define VM_WAIT() asm volatile("s_waitcnt vmcnt(0)" ::: "memory")

#define XB_TMO      128
#define XB_XCNT(j)  (256  + 64 * (j))
#define XB_XSUB(j)  (1280 + 64 * (j))
#define XB_XGEN(j)  (2304 + 64 * (j))
#define XB_TOP      3328
#define XB_TOPGEN   3392
#define XCD_BAR_WORDS 3456
#define XB_SPIN_CAP (1u << 20)
__device__ __forceinline__ unsigned xb_ld(unsigned* p)              { return __hip_atomic_load(p, __ATOMIC_RELAXED, __HIP_MEMORY_SCOPE_AGENT); }
__device__ __forceinline__ unsigned xb_add(unsigned* p, unsigned v) { return __hip_atomic_fetch_add(p, v, __ATOMIC_RELAXED, __HIP_MEMORY_SCOPE_AGENT); }
__device__ __forceinline__ unsigned xb_xcc_id() { return (unsigned)__builtin_amdgcn_s_getreg((3 << 11) | 20) & 0xFu; }
#define XB_SPIN(cond, bar) do { unsigned _sp = 0; while (cond) { __builtin_amdgcn_s_sleep(1); \
    if ((++_sp & 255u) == 0u) { if (xb_ld(&(bar)[XB_TMO])) break; if (_sp > XB_SPIN_CAP) { atomicAdd(&(bar)[XB_TMO], 1u); break; } } } } while (0)
struct XcdBarrier { unsigned* bar; unsigned x; volatile LAS unsigned* st; };
__device__ __forceinline__ XcdBarrier xcd_barrier_post(unsigned* bar, volatile LAS unsigned* st) {
    XcdBarrier b; b.bar = bar; b.x = xb_xcc_id(); b.st = st;
    if (threadIdx.x == 0) (void)xb_add(&bar[XB_XCNT(b.x)], 1u);
    return b;
}
__device__ __forceinline__ void xcd_barrier_complete(unsigned* bar, unsigned x, unsigned& nloc, unsigned& nx) {
    const unsigned G = gridDim.x * gridDim.y * gridDim.z;
    unsigned sum, cnt, mine, sp = 0u;
    for (;;) {
        sum = 0u; cnt = 0u; mine = 0u;
#pragma unroll
        for (unsigned j = 0; j < 16; ++j) { const unsigned c = xb_ld(&bar[XB_XCNT(j)]); sum += c; cnt += (c > 0u) ? 1u : 0u; mine = (j == x) ? c : mine; }
        if (sum == G) break;
        __builtin_amdgcn_s_sleep(1);
        if ((++sp & 255u) == 0u) { if (xb_ld(&bar[XB_TMO])) break; if (sp > XB_SPIN_CAP) { atomicAdd(&bar[XB_TMO], 1u); break; } }
    }
    nloc = mine > 0u ? mine : 1u; nx = cnt > 0u ? cnt : 1u;
}
__device__ __forceinline__ void xcd_barrier(const XcdBarrier& b) {
    asm volatile("s_waitcnt vmcnt(0)" ::: "memory");
    __syncthreads();
    if (threadIdx.x == 0) {
        unsigned* bar = b.bar;
        __builtin_amdgcn_s_waitcnt(0);
        unsigned nloc = b.st[0], nx = b.st[1];
        if (nloc == 0u) { xcd_barrier_complete(bar, b.x, nloc, nx); b.st[0] = nloc; b.st[1] = nx; }
        const unsigned old = xb_add(&bar[XB_XSUB(b.x)], 1u);
        const unsigned gen = old / nloc;
        if (old + 1u == (gen + 1u) * nloc) {
            __builtin_amdgcn_fence(__ATOMIC_RELEASE, "agent");
            asm volatile("s_waitcnt vmcnt(0)" ::: "memory");
            const unsigned og = xb_add(&bar[XB_TOP], 1u);
            const unsigned tg = og / nx;
            if (og + 1u == (tg + 1u) * nx) xb_add(&bar[XB_TOPGEN], 1u);
            else XB_SPIN(xb_ld(&bar[XB_TOPGEN]) == tg, bar);
            __builtin_amdgcn_fence(__ATOMIC_ACQUIRE, "agent");
            xb_add(&bar[XB_XGEN(b.x)], 1u);
            asm volatile("s_waitcnt vmcnt(0)" ::: "memory");
        } else {
            XB_SPIN(xb_ld(&bar[XB_XGEN(b.x)]) == gen, bar);
            __builtin_amdgcn_fence(__ATOMIC_ACQUIRE, "agent");
            asm volatile("s_waitcnt vmcnt(0)" ::: "memory");
        }
    }
    __syncthreads();
}

struct Frame {
    LAS unsigned char* lds;
    volatile LAS unsigned* MISC;
    unsigned* ctl;
    int tid, lane, wave, vcu, G;
    const float *x, *ng, *w_in, *conv_w, *w_out, *rel_bias, *fg; float* out;
    bf16_t *WinT, *WoutT, *U, *PROJ, *MIX, *PART; float *LSE, *KSUM, *ROWSS; unsigned short* LIST; int* CNT;
};

__device__ __forceinline__ float wave_sum(float v) {
#pragma unroll
    for (int o = 1; o < 64; o <<= 1) v += __shfl_xor(v, o);
    return v;
}

__device__ __forceinline__ void p0_tile_load(f32x4 (&v)[8], const float* W, int N, int kb, int nb, int wave, int lane) {
    const float* src = W + (size_t)(64 * kb + 8 * wave) * N + 256 * nb + 4 * lane;
#pragma unroll
    for (int i = 0; i < 8; ++i) v[i] = *(const f32x4*)(src + (size_t)i * N);
}
__device__ __forceinline__ void p0_tile_store(const f32x4 (&v)[8], bf16_t* WT, int kb, int nb, LAS unsigned* T, int tid, int wave, int lane) {
#pragma unroll
    for (int ii = 0; ii < 4; ++ii) { const int kp = 4 * wave + ii; u32x4 d;
        d.x = cvtpk(v[2 * ii][0], v[2 * ii + 1][0]); d.y = cvtpk(v[2 * ii][1], v[2 * ii + 1][1]); d.z = cvtpk(v[2 * ii][2], v[2 * ii + 1][2]); d.w = cvtpk(v[2 * ii][3], v[2 * ii + 1][3]);
        *(LAS u32x4*)(T + kp * 256 + ((4 * lane) ^ (wave << 2))) = d; }
    LDS_WAIT(); __syncthreads();
#pragma unroll
    for (int i = 0; i < 4; ++i) { const int idx = tid + 512 * i, n = idx >> 3, c = idx & 7; u32x4 o;
        const LAS unsigned* tp = T + (4 * c) * 256 + (n ^ (c << 2));
        o.x = tp[0]; o.y = tp[256]; o.z = tp[512]; o.w = tp[768];
        *(u32x4*)(WT + (size_t)(256 * nb + n) * 4096 + 64 * kb + 8 * c) = o; }
    LDS_WAIT(); __syncthreads();
}
__device__ __forceinline__ void p0_decode(int it, const float* w_in, const float* w_out, bf16_t* WinT, bf16_t* WoutT, const float*& W, int& N, bf16_t*& WT, int& kb, int& nb) {
    if (it < 4096) { W = w_in; N = PW; WT = WinT; nb = it & 63; kb = it >> 6; }
    else { const int r = it - 4096; W = w_out; N = DM; WT = WoutT; nb = r & 15; kb = r >> 4; }
}
__device__ __forceinline__ void p0_prologue(Frame& F) {
    { const int gt = F.vcu * 512 + F.tid, NT = F.G * 512; for (int i = gt; i < NB * 2048 / 4; i += NT) ((f32x4*)F.KSUM)[i] = (f32x4){0.f, 0.f, 0.f, 0.f}; }
    {
        LAS unsigned* T = (LAS unsigned*)F.lds;
        constexpr int NIT = 4096 + 1024;
        f32x4 va[8], vb[8]; const float* W; int N, kb, nb; bf16_t* WT;
        int it = F.vcu;
        if (it < NIT) { p0_decode(it, F.w_in, F.w_out, F.WinT, F.WoutT, W, N, WT, kb, nb); p0_tile_load(va, W, N, kb, nb, F.wave, F.lane); }
        while (it < NIT) {
            const float* W2; int N2, kb2, nb2; bf16_t* WT2; const int it2 = it + F.G;
            if (it2 < NIT) { p0_decode(it2, F.w_in, F.w_out, F.WinT, F.WoutT, W2, N2, WT2, kb2, nb2); p0_tile_load(vb, W2, N2, kb2, nb2, F.wave, F.lane); }
            p0_tile_store(va, WT, kb, nb, T, F.tid, F.wave, F.lane);
            it = it2; if (it >= NIT) break;
            const int it3 = it + F.G;
            if (it3 < NIT) { p0_decode(it3, F.w_in, F.w_out, F.WinT, F.WoutT, W, N, WT, kb, nb); p0_tile_load(va, W, N, kb, nb, F.wave, F.lane); }
            p0_tile_store(vb, WT2, kb2, nb2, T, F.tid, F.wave, F.lane);
            it = it3;
        }
    }
    {
        const int gw = F.vcu * NWAVES + F.wave, NGW = F.G * NWAVES;
        for (int row = gw; row < SEQ; row += NGW) {
            const f32x4* xr = (const f32x4*)(F.x + (size_t)row * DM) + F.lane; f32x4 v[16]; float ss = 0.f;
#pragma unroll
            for (int j = 0; j < 16; ++j) { v[j] = xr[64 * j]; ss += (v[j][0] * v[j][0] + v[j][1] * v[j][1]) + (v[j][2] * v[j][2] + v[j][3] * v[j][3]); }
            const float rstd = 1.0f / sqrtf(wave_sum(ss) * (1.f / DM) + EPS);
            const f32x4* gr = (const f32x4*)F.ng + F.lane; u32x2* o8 = (u32x2*)(F.U + (size_t)row * DM) + F.lane;
#pragma unroll
            for (int j = 0; j < 16; ++j) { const f32x4 g = gr[64 * j]; u32x2 w; w.x = cvtpk(v[j][0] * rstd * g[0], v[j][1] * rstd * g[1]); w.y = cvtpk(v[j][2] * rstd * g[2], v[j][3] * rstd * g[3]); o8[64 * j] = w; }
        }
    }
}

#define TOP_BETTER(v, i, w, k) ((v) > (w) || ((v) == (w) && (i) < (k)))
#define TOP_INSERT(v, i) do { if (TOP_BETTER(v, i, v0, i0)) { v2 = v1; i2 = i1; v1 = v0; i1 = i0; v0 = (v); i0 = (i); } \
    else if (TOP_BETTER(v, i, v1, i1)) { v2 = v1; i2 = i1; v1 = (v); i1 = (i); } else if (TOP_BETTER(v, i, v2, i2)) { v2 = (v); i2 = (i); } } while (0)
__device__ __forceinline__ void p2_route(Frame& F) {
    LAS int* lcnt = (LAS int*)F.lds;
    const int r32 = F.lane & 31, hi = F.lane >> 5;
    for (int u = F.vcu; u < NH * (NB - 1); u += F.G) {
        const int h = u & 15, qb = 1 + (u >> 4);
        if (F.tid < 32) lcnt[F.tid] = 0;
        __syncthreads();
        bf16x8 khi[8], klo[8], q[8];
        const float* kp = F.KSUM + (size_t)r32 * 2048 + h * HD + 8 * hi;
        const int ql = 32 * F.wave + r32, s = qb * BLK + ql;
        const bf16_t* qp = F.PROJ + (size_t)s * PW + COL_Q + h * HD + 8 * hi;
#pragma unroll
        for (int st = 0; st < 8; ++st) {
            const f32x4 a = *(const f32x4*)(kp + 16 * st), b = *(const f32x4*)(kp + 16 * st + 4);
            float f[8] = {a[0], a[1], a[2], a[3], b[0], b[1], b[2], b[3]}; u32x4 wh, wl; unsigned hh[4], ll[4];
#pragma unroll
            for (int e = 0; e < 4; ++e) { const float x0 = f[2 * e] * (1.f / 256.f), x1 = f[2 * e + 1] * (1.f / 256.f); const unsigned w = cvtpk(x0, x1); hh[e] = w; ll[e] = cvtpk(x0 - bf_lo(w), x1 - bf_hi(w)); }
            wh = (u32x4){hh[0], hh[1], hh[2], hh[3]}; wl = (u32x4){ll[0], ll[1], ll[2], ll[3]};
            khi[st] = __builtin_bit_cast(bf16x8, wh); klo[st] = __builtin_bit_cast(bf16x8, wl);
            q[st] = *(const bf16x8*)(qp + 16 * st);
        }
        f32x16 acc; for (int r = 0; r < 16; ++r) acc[r] = 0.f;
#pragma unroll
        for (int st = 0; st < 8; ++st) { acc = __builtin_amdgcn_mfma_f32_32x32x16_bf16(khi[st], q[st], acc, 0, 0, 0); acc = __builtin_amdgcn_mfma_f32_32x32x16_bf16(klo[st], q[st], acc, 0, 0, 0); }
        float v0 = -INFINITY, v1 = -INFINITY, v2 = -INFINITY; int i0 = 64, i1 = 65, i2 = 66;
#pragma unroll
        for (int r = 0; r < 16; ++r) { const int blk = crow(r, hi); const float v = (blk < qb) ? acc[r] : -INFINITY; TOP_INSERT(v, blk); }
        { const float p0 = __shfl_xor(v0, 32), p1 = __shfl_xor(v1, 32), p2 = __shfl_xor(v2, 32); const int j0 = __shfl_xor(i0, 32), j1 = __shfl_xor(i1, 32), j2 = __shfl_xor(i2, 32);
          TOP_INSERT(p0, j0); TOP_INSERT(p1, j1); TOP_INSERT(p2, j2); }
        const int nv = qb < 3 ? qb : 3;
        if (hi == 0) {
            const int sel[3] = {i0, i1, i2};
#pragma unroll
            for (int r = 0; r < 3; ++r) if (r < nv) { const int n = sel[r]; const int pos = __hip_atomic_fetch_add(lcnt + n, 1, __ATOMIC_RELAXED, __HIP_MEMORY_SCOPE_WORKGROUP);
                F.LIST[(((size_t)h * NB + n) * NB + qb) * BLK + pos] = (unsigned short)(ql | (r << 8)); }
        }
        LDS_WAIT(); __syncthreads();
        if (F.tid < qb) F.CNT[((size_t)h * NB + F.tid) * NB + qb] = lcnt[F.tid];
        __syncthreads();
    }
}

constexpr int N_ITEMS_PER_HEAD = 95;
__device__ __forceinline__ void item_decode(int e, int& j, int& lo, int& hq, int& own) {
    constexpr int ARB[8] = {1, 3, 5, 8, 12, 17, 24, 32};
    constexpr int CUM[8] = {0, 2, 6, 13, 24, 40, 63, 94};
    j = 31; lo = 32; hq = 32; own = 1;
#pragma unroll
    for (int ri = 0; ri < 7; ++ri) if (e >= CUM[ri] && e < CUM[ri + 1]) { j = e - CUM[ri]; lo = ARB[ri] > j + 1 ? ARB[ri] : j + 1; hq = ARB[ri + 1]; own = (ri == 0 || ARB[ri] <= j + 1) ? 1 : 0; }
}

template <bool GENERAL>
__device__ __forceinline__ void att_tile(const LAS unsigned char* Kl, const LAS unsigned char* Vl, const LAS float* lutp, float c31, int nkt,
                                         const bf16x8 (&qr)[8], int r32, int hi, int lane, float& m_out, float& l_out, f32x16 (&o)[4]) {
    float m = -1e30f, l = 0.f;
#pragma unroll
    for (int d0 = 0; d0 < 4; ++d0) for (int r = 0; r < 16; ++r) o[d0][r] = 0.f;
    const int X = (r32 & 15) << 4;
    const int i16 = lane & 15, qq = i16 >> 2, pp = i16 & 3, blk = (lane >> 4) & 1;
    int vb[4];
#pragma unroll
    for (int d0 = 0; d0 < 4; ++d0) vb[d0] = 256 * (4 * hi + qq) + 16 * (4 * (d0 ^ qq) + 2 * blk + (pp >> 1)) + 8 * (pp & 1);
    for (int kt = 0; kt < nkt; ++kt) {
        f32x16 p0, p1;
#pragma unroll
        for (int r = 0; r < 16; ++r) { p0[r] = 0.f; p1[r] = 0.f; }
        const LAS unsigned char* kr = Kl + 256 * (64 * kt + r32);
#pragma unroll
        for (int st = 0; st < 8; ++st) {
            const int cb = (32 * st + 16 * hi) ^ X;
            const bf16x8 a0 = *(const LAS bf16x8*)(kr + cb), a1 = *(const LAS bf16x8*)(kr + 32 * 256 + cb);
            p0 = __builtin_amdgcn_mfma_f32_32x32x16_bf16(a0, qr[st], p0, 0, 0, 0);
            p1 = __builtin_amdgcn_mfma_f32_32x32x16_bf16(a1, qr[st], p1, 0, 0, 0);
        }
        if (GENERAL) {
            const LAS float* lp = lutp - 64 * kt;
#pragma unroll
            for (int r = 0; r < 16; ++r) { const int kk = (r & 3) + 8 * (r >> 2); p0[r] = fmaf(p0[r], QK_C, lp[-kk]); p1[r] = fmaf(p1[r], QK_C, lp[-kk - 32]); }
        } else {
#pragma unroll
            for (int r = 0; r < 16; ++r) { p0[r] = fmaf(p0[r], QK_C, c31); p1[r] = fmaf(p1[r], QK_C, c31); }
        }
        float pmax = fmaxf(p0[0], p1[0]);
#pragma unroll
        for (int r = 1; r < 16; ++r) pmax = fmaxf(pmax, fmaxf(p0[r], p1[r]));
        { auto rr = __builtin_amdgcn_permlane32_swap(__float_as_uint(pmax), __float_as_uint(pmax), false, false); pmax = fmaxf(__uint_as_float(rr[0]), __uint_as_float(rr[1])); }
        const float mn = fmaxf(m, pmax);
        if (__any(mn > m)) {
            const float alpha = __builtin_amdgcn_exp2f(m - mn);
            l *= alpha;
#pragma unroll
            for (int d0 = 0; d0 < 4; ++d0) for (int r = 0; r < 16; ++r) o[d0][r] *= alpha;
            m = mn;
        }
        float ps = 0.f;
#pragma unroll
        for (int r = 0; r < 16; ++r) { p0[r] = __builtin_amdgcn_exp2f(p0[r] - m); p1[r] = __builtin_amdgcn_exp2f(p1[r] - m); ps += p0[r] + p1[r]; }
        l += ps;
        bf16x8 pb[4];
#pragma unroll
        for (int s2 = 0; s2 < 2; ++s2) {
            u32x4 w0 = {cvtpk(p0[8 * s2], p0[8 * s2 + 1]), cvtpk(p0[8 * s2 + 2], p0[8 * s2 + 3]), cvtpk(p0[8 * s2 + 4], p0[8 * s2 + 5]), cvtpk(p0[8 * s2 + 6], p0[8 * s2 + 7])};
            u32x4 w1 = {cvtpk(p1[8 * s2], p1[8 * s2 + 1]), cvtpk(p1[8 * s2 + 2], p1[8 * s2 + 3]), cvtpk(p1[8 * s2 + 4], p1[8 * s2 + 5]), cvtpk(p1[8 * s2 + 6], p1[8 * s2 + 7])};
            pb[s2] = __builtin_bit_cast(bf16x8, w0); pb[2 + s2] = __builtin_bit_cast(bf16x8, w1);
        }
        const LAS unsigned char* vt = Vl + 256 * 64 * kt;
#pragma unroll
        for (int d0 = 0; d0 < 4; ++d0)
#pragma unroll
            for (int ks = 0; ks < 4; ++ks) {
                const LAS unsigned char* vp = vt + vb[d0] + 256 * 16 * ks;
                const s16x4 lo4 = __builtin_bit_cast(s16x4, __builtin_amdgcn_ds_read_tr16_b64_v4i16((LAS s16x4*)(vp)));
                const s16x4 hi4 = __builtin_bit_cast(s16x4, __builtin_amdgcn_ds_read_tr16_b64_v4i16((LAS s16x4*)(vp + 256 * 8)));
                const bf16x8 va = __builtin_shufflevector(lo4, hi4, 0, 1, 2, 3, 4, 5, 6, 7);
                o[d0] = __builtin_amdgcn_mfma_f32_32x32x16_bf16(va, pb[ks], o[d0], 0, 0, 0);
            }
    }
    m_out = m; l_out = l;
}

__device__ __forceinline__ void p3_attention(Frame& F) {
    LAS unsigned char* Kl = F.lds; LAS unsigned char* Vl = F.lds + 65536;
    LAS float* lut = (LAS float*)(F.lds + ATT_LUT_OFF);
    LAS int* misc = (LAS int*)(F.lds + ATT_MISC_OFF);
    const int r32 = F.lane & 31, hi = F.lane >> 5;
    const int NITEMS = N_ITEMS_PER_HEAD * NH;
    for (;;) {
        if (F.tid == 0) misc[0] = (int)__hip_atomic_fetch_add(F.ctl + CW_ITEM, 1u, RLX_AGENT);
        LDS_WAIT(); __syncthreads();
        const int item = __builtin_amdgcn_readfirstlane(misc[0]);
        if (item >= NITEMS) break;
        const int h = item & 15, e = item >> 4;
        int j, lo, hq, own; item_decode(e, j, lo, hq, own);
        const int nsub = hq - lo;
        {
            const bf16_t* kg = F.PROJ + (size_t)(j * BLK) * PW + COL_K + h * HD; const bf16_t* vg = F.PROJ + (size_t)(j * BLK) * PW + COL_V + h * HD;
            u32x4 kv[8], vv[8];
#pragma unroll
            for (int i = 0; i < 8; ++i) { const int p = F.tid + 512 * i, row = p >> 4, ch = p & 15; kv[i] = *(const u32x4*)(kg + (size_t)row * PW + 8 * ch); vv[i] = *(const u32x4*)(vg + (size_t)row * PW + 8 * ch); }
#pragma unroll
            for (int i = 0; i < 8; ++i) { const int p = F.tid + 512 * i, row = p >> 4, ch = p & 15;
                *(LAS u32x4*)(Kl + 256 * row + ((16 * ch) ^ ((row & 15) << 4))) = kv[i];
                *(LAS u32x4*)(Vl + 256 * row + 16 * (ch ^ ((row & 3) << 2))) = vv[i]; }
        }
        for (int i = F.tid; i < 768; i += 512) {
            const int dist = i - 255; float v;
            if (dist < 0) v = -INFINITY;
            else { int b; if (dist < 16) b = dist; else { b = 16 + (int)(logf((float)dist * (1.f / 16.f)) / logf(8.f) * 16.f); b = b > 31 ? 31 : b; }
                   v = F.rel_bias[b * NH + h] * LOG2E; }
            lut[i] = v;
        }
        if (F.tid == 0) { int acc = own ? BLK : 0; misc[8] = acc; for (int k = 0; k < nsub; ++k) { acc += F.CNT[((size_t)h * NB + j) * NB + lo + k]; misc[9 + k] = acc; } }
        LDS_WAIT(); __syncthreads();
        const int nown = own ? BLK : 0;
        const int total = misc[8 + nsub];
        const float c31 = F.rel_bias[31 * NH + h] * LOG2E;
        const int NT = (total + 31) >> 5;
        for (int t = F.wave; t < NT; t += NWAVES) {
            const int e0 = 32 * t + r32; const bool valid = e0 < total; const int ee = valid ? e0 : total - 1;
            int qb, ql, slot;
            if (ee < nown) { qb = j; ql = ee; slot = 3; }
            else {
                int k = 0;
#pragma unroll
                for (int kk = 1; kk < 8; ++kk) if (kk < nsub && ee >= misc[8 + kk]) k = kk;
                qb = lo + k; const unsigned ent = F.LIST[(((size_t)h * NB + j) * NB + qb) * BLK + (ee - misc[8 + k])]; ql = ent & 255; slot = ent >> 8;
            }
            const int s = qb * BLK + ql; const int dbase = (qb - j) * BLK + ql; const int dbc = dbase < 511 ? dbase : 511;
            const bool own_tile = (32 * t) < nown;
            const int nkt = own_tile ? ((t >> 1) + 1) : 4;
            bf16x8 qr[8];
            const bf16_t* qp = F.PROJ + (size_t)s * PW + COL_Q + h * HD + 8 * hi;
#pragma unroll
            for (int st = 0; st < 8; ++st) qr[st] = *(const bf16x8*)(qp + 16 * st);
            f32x16 o[4]; float m, l;
            const bool general = !__all(dbase >= 368);
            if (general) att_tile<true>(Kl, Vl, lut + (dbc + 255 - 4 * hi), c31, nkt, qr, r32, hi, F.lane, m, l, o);
            else att_tile<false>(Kl, Vl, lut, c31, nkt, qr, r32, hi, F.lane, m, l, o);
            { auto rr = __builtin_amdgcn_permlane32_swap(__float_as_uint(l), __float_as_uint(l), false, false); l = __uint_as_float(rr[0]) + __uint_as_float(rr[1]); }
            const float inv = 1.0f / l;
            if (valid) {
                bf16_t* op = F.PART + (((size_t)s * NH + h) * 4 + slot) * HD + 4 * hi;
#pragma unroll
                for (int d0 = 0; d0 < 4; ++d0)
#pragma unroll
                    for (int g = 0; g < 4; ++g) { u32x2 w; w.x = cvtpk(o[d0][4 * g] * inv, o[d0][4 * g + 1] * inv); w.y = cvtpk(o[d0][4 * g + 2] * inv, o[d0][4 * g + 3] * inv); *(u32x2*)(op + 32 * d0 + 8 * g) = w; }
                if (hi == 0) F.LSE[((size_t)s * NH + h) * 4 + slot] = m + __log2f(l);
            }
        }
        __syncthreads();
    }
}

__device__ __forceinline__ void p4_mix(Frame& F) {
    const int gt = F.vcu * 512 + F.tid, NT = F.G * 512;
    for (int idx = gt; idx < SEQ * NH * 16; idx += NT) {
        const int c = idx & 15, h = (idx >> 4) & 15, s = idx >> 8; const int qb = s >> 8, nv = qb < 3 ? qb : 3;
        const f32x4 L = *(const f32x4*)(F.LSE + ((size_t)s * NH + h) * 4);
        float M = L[3]; for (int r = 0; r < 3; ++r) if (r < nv) M = fmaxf(M, L[r]);
        float w[4]; float ws = 0.f;
        for (int r = 0; r < 3; ++r) { w[r] = (r < nv) ? __builtin_amdgcn_exp2f(L[r] - M) : 0.f; ws += w[r]; }
        w[3] = __builtin_amdgcn_exp2f(L[3] - M); ws += w[3];
        const float inv = 1.0f / ws;
        float acc[8] = {0.f, 0.f, 0.f, 0.f, 0.f, 0.f, 0.f, 0.f};
        const bf16_t* pp = F.PART + (((size_t)s * NH + h) * 4) * HD + 8 * c;
#pragma unroll
        for (int r = 0; r < 4; ++r) if (r == 3 || r < nv) { const u32x4 v = *(const u32x4*)(pp + r * HD); const float wr_ = w[r] * inv;
            acc[0] += wr_ * bf_lo(v.x); acc[1] += wr_ * bf_hi(v.x); acc[2] += wr_ * bf_lo(v.y); acc[3] += wr_ * bf_hi(v.y);
            acc[4] += wr_ * bf_lo(v.z); acc[5] += wr_ * bf_hi(v.z); acc[6] += wr_ * bf_lo(v.w); acc[7] += wr_ * bf_hi(v.w); }
        const u32x4 z = *(const u32x4*)(F.PROJ + (size_t)s * PW + COL_ZA + h * HD + 8 * c);
        u32x4 o;
        o.x = cvtpk(acc[0] * silu_f(bf_lo(z.x)), acc[1] * silu_f(bf_hi(z.x))); o.y = cvtpk(acc[2] * silu_f(bf_lo(z.y)), acc[3] * silu_f(bf_hi(z.y)));
        o.z = cvtpk(acc[4] * silu_f(bf_lo(z.z)), acc[5] * silu_f(bf_hi(z.z))); o.w = cvtpk(acc[6] * silu_f(bf_lo(z.w)), acc[7] * silu_f(bf_hi(z.w)));
        *(u32x4*)(F.MIX + (size_t)s * DM + h * HD + 8 * c) = o;
    }
    for (int idx = gt; idx < SEQ * 256; idx += NT) {
        const int c8 = idx & 255, s = idx >> 8, ch = 8 * c8;
        float t[3][8];
#pragma unroll
        for (int k = 0; k < 3; ++k) {
            const int sp = s - 2 + k;
            if (sp >= 0) { const u32x4 hv = *(const u32x4*)(F.PROJ + (size_t)sp * PW + COL_HC + ch), cv = *(const u32x4*)(F.PROJ + (size_t)sp * PW + COL_CG + ch);
                t[k][0] = bf_lo(hv.x) * bf_lo(cv.x); t[k][1] = bf_hi(hv.x) * bf_hi(cv.x); t[k][2] = bf_lo(hv.y) * bf_lo(cv.y); t[k][3] = bf_hi(hv.y) * bf_hi(cv.y);
                t[k][4] = bf_lo(hv.z) * bf_lo(cv.z); t[k][5] = bf_hi(hv.z) * bf_hi(cv.z); t[k][6] = bf_lo(hv.w) * bf_lo(cv.w); t[k][7] = bf_hi(hv.w) * bf_hi(cv.w); }
            else { for (int e = 0; e < 8; ++e) t[k][e] = 0.f; }
        }
        const u32x4 bv = *(const u32x4*)(F.PROJ + (size_t)s * PW + COL_BG + ch), zv = *(const u32x4*)(F.PROJ + (size_t)s * PW + COL_ZC + ch);
        const float bg[8] = {bf_lo(bv.x), bf_hi(bv.x), bf_lo(bv.y), bf_hi(bv.y), bf_lo(bv.z), bf_hi(bv.z), bf_lo(bv.w), bf_hi(bv.w)};
        const float zc[8] = {bf_lo(zv.x), bf_hi(zv.x), bf_lo(zv.y), bf_hi(zv.y), bf_lo(zv.z), bf_hi(zv.z), bf_lo(zv.w), bf_hi(zv.w)};
        float y[8];
#pragma unroll
        for (int e = 0; e < 8; ++e) { const float w0 = F.conv_w[ch + e], w1 = F.conv_w[2048 + ch + e], w2 = F.conv_w[4096 + ch + e];
            y[e] = bg[e] * (t[0][e] * w0 + t[1][e] * w1 + t[2][e] * w2) * silu_f(zc[e]); }
        u32x4 o; o.x = cvtpk(y[0], y[1]); o.y = cvtpk(y[2], y[3]); o.z = cvtpk(y[4], y[5]); o.w = cvtpk(y[6], y[7]);
        *(u32x4*)(F.MIX + (size_t)s * DM + AW + ch) = o;
    }
}

__device__ __forceinline__ void p6_final(Frame& F) {
    const int gw = F.vcu * NWAVES + F.wave, NGW = F.G * NWAVES;
    for (int row = gw; row < SEQ; row += NGW) {
        const float ss = wave_sum(F.ROWSS[(size_t)row * 64 + F.lane]);
        const float rstd = 1.0f / sqrtf(ss * (1.f / DM) + EPS);
        f32x4* orow = (f32x4*)(F.out + (size_t)row * DM) + F.lane; const f32x4* gr = (const f32x4*)F.fg + F.lane;
        f32x4 v[16];
#pragma unroll
        for (int j = 0; j < 16; ++j) v[j] = orow[64 * j];
#pragma unroll
        for (int j = 0; j < 16; ++j) { const f32x4 g = gr[64 * j]; f32x4 r; r[0] = v[j][0] * rstd * g[0]; r[1] = v[j][1] * rstd * g[1]; r[2] = v[j][2] * rstd * g[2]; r[3] = v[j][3] * rstd * g[3]; orow[64 * j] = r; }
    }
}

struct Args { const float* x; const float* ng; const float* w_in; const float* conv_w; const float* w_out; const float* rel_bias; const float* fg; float* out; unsigned char* ws; int ph_lo, ph_hi; };
__global__ void __launch_bounds__(NWAVES * 64, 2) mk_fwd(Args args) {
    extern __shared__ __attribute__((aligned(16))) unsigned char lds[];
    Frame F;
    F.lds = (LAS unsigned char*)lds;
    F.MISC = (volatile LAS unsigned*)(F.lds + MISC_OFF);
    F.tid = threadIdx.x; F.lane = F.tid & 63; F.wave = __builtin_amdgcn_readfirstlane(F.tid >> 6);
    F.G = gridDim.x; { const int bx = blockIdx.x; F.vcu = (F.G % 8 == 0) ? (bx % 8) * (F.G / 8) + bx / 8 : bx; }
    unsigned char* ws = args.ws;
    F.ctl = (unsigned*)(ws + WS_CTL);
    F.x = args.x; F.ng = args.ng; F.w_in = args.w_in; F.conv_w = args.conv_w; F.w_out = args.w_out; F.rel_bias = args.rel_bias; F.fg = args.fg; F.out = args.out;
    F.WinT = (bf16_t*)(ws + WS_WIN); F.WoutT = (bf16_t*)(ws + WS_WOUT); F.U = (bf16_t*)(ws + WS_U); F.PROJ = (bf16_t*)(ws + WS_PROJ); F.MIX = (bf16_t*)(ws + WS_MIX); F.PART = (bf16_t*)(ws + WS_PART);
    F.LSE = (float*)(ws + WS_LSE); F.KSUM = (float*)(ws + WS_KSUM); F.ROWSS = (float*)(ws + WS_ROWSS); F.LIST = (unsigned short*)(ws + WS_LIST); F.CNT = (int*)(ws + WS_CNT);
    for (int u = F.tid; u < (LDS_BYTES - LDSCTL_OFF) / 4; u += NWAVES * 64) ((LAS unsigned*)(F.lds + LDSCTL_OFF))[u] = 0u;
    __syncthreads();
    XcdBarrier bar; bar.bar = F.ctl + CW_BAR; bar.x = 0; bar.st = nullptr;
    if (N_LAUNCHES == 1) bar = xcd_barrier_post(F.ctl + CW_BAR, F.MISC + 8);
#define GRID_BAR() do { if (N_LAUNCHES == 1) xcd_barrier(bar); } while (0)
    const int lo = args.ph_lo, hi = args.ph_hi;
#define IN(k) (lo <= (k) && (k) < hi)
#define BOTH(k) (IN(k) && IN((k) + 1))
    if (IN(0)) { p0_prologue(F); if (BOTH(0)) GRID_BAR(); }
    if (IN(1)) {
        pg8::Gemm g{F.U, F.WinT, SEQ, PW, DM}; pg8::StaticOrder S; S.init(SEQ, PW, F.G, (int)blockIdx.x);
        pg8::EpiProj E{F.PROJ, PW, F.KSUM};
        pg8::gemm_phase<pg8::EpiProj, pg8::StaticOrder, true, true>(F.lds, g, S, E);
        if (BOTH(1)) GRID_BAR();
    }
    if (IN(2)) { p2_route(F); if (BOTH(2)) GRID_BAR(); }
    if (IN(3)) { p3_attention(F); if (BOTH(3)) GRID_BAR(); }
    if (IN(4)) { p4_mix(F); if (BOTH(4)) GRID_BAR(); }
    if (IN(5)) {
        pg8::Gemm g{F.MIX, F.WoutT, SEQ, DM, DM}; pg8::StaticOrder S; S.init(SEQ, DM, F.G, (int)blockIdx.x);
        pg8::EpiOut E{F.x, F.out, F.ROWSS};
        pg8::gemm_phase<pg8::EpiOut, pg8::StaticOrder, true, true>(F.lds, g, S, E);
        if (BOTH(5)) GRID_BAR();
    }
    if (IN(6)) { p6_final(F); }
#undef IN
#undef BOTH
}

extern "C" void kernel_launch(void* const* d_in, const int* in_sizes, int n_in, void* d_out, int out_size, void* d_ws, size_t ws_size, hipStream_t stream) {
    static int grid = 0;
    if (grid == 0) {
        if (n_in != 7 || in_sizes[0] != SEQ * DM || out_size != SEQ * DM || ws_size < WS_END) {
            fprintf(stderr, "kernel_launch: unexpected shapes (n_in %d, in0 %d, out %d, ws %zu); nothing launched\n", n_in, n_in > 0 ? in_sizes[0] : -1, out_size, ws_size); grid = -1; return; }
        int dev = 0, cus = 0, per_cu = 0;
        if (hipGetDevice(&dev) != hipSuccess || hipDeviceGetAttribute(&cus, hipDeviceAttributeMultiprocessorCount, dev) != hipSuccess) { fprintf(stderr, "kernel_launch: device query failed\n"); grid = -1; return; }
        if (hipFuncSetAttribute((const void*)mk_fwd, hipFuncAttributeMaxDynamicSharedMemorySize, LDS_BYTES) != hipSuccess) { fprintf(stderr, "kernel_launch: hipFuncSetAttribute failed\n"); grid = -1; return; }
        if (hipOccupancyMaxActiveBlocksPerMultiprocessor(&per_cu, (const void*)mk_fwd, NWAVES * 64, LDS_BYTES) != hipSuccess || per_cu < 1) {
            fprintf(stderr, "kernel_launch: occupancy query reports %d workgroups per CU\n", per_cu); (void)hipGetLastError(); grid = -1; return; }
        grid = cus;
    }
    if (grid < 0) return;
    (void)hipMemsetAsync((char*)d_ws + WS_CTL, 0, CTL_ZERO_BYTES, stream);
    Args a{};
    a.x = (const float*)d_in[0]; a.ng = (const float*)d_in[1]; a.w_in = (const float*)d_in[2]; a.conv_w = (const float*)d_in[3]; a.w_out = (const float*)d_in[4];
    a.rel_bias = (const float*)d_in[5]; a.fg = (const float*)d_in[6]; a.out = (float*)d_out; a.ws = (unsigned char*)d_ws;
    if (N_LAUNCHES == 1) { a.ph_lo = 0; a.ph_hi = N_PHASES; hipLaunchKernelGGL(mk_fwd, dim3(grid), dim3(NWAVES * 64), LDS_BYTES, stream, a); }
    else { for (int p = 0; p < N_PHASES; ++p) { a.ph_lo = p; a.ph_hi = p + 1; hipLaunchKernelGGL(mk_fwd, dim3(grid), dim3(NWAVES * 64), LDS_BYTES, stream, a); } }
}
```

```cpp
#include <hip/hip_runtime.h>
#include <cstdio>
#include <cstdint>
#include <cmath>

#ifndef MK_DOUBLE
#define MK_DOUBLE -1
#endif
#ifndef MK_N_LAUNCHES
#define MK_N_LAUNCHES 1
#endif

#define LAS __attribute__((address_space(3)))
#define GAS __attribute__((address_space(1)))
typedef unsigned short bf16_t;
typedef short bf16x8 __attribute__((ext_vector_type(8)));
typedef short s16x4 __attribute__((ext_vector_type(4)));
typedef float f32x4 __attribute__((ext_vector_type(4)));
typedef float f32x16 __attribute__((ext_vector_type(16)));
typedef unsigned u32x4 __attribute__((ext_vector_type(4)));
typedef unsigned u32x2 __attribute__((ext_vector_type(2)));
typedef float f32x2_t __attribute__((ext_vector_type(2)));
typedef __bf16 bf16x2_t __attribute__((ext_vector_type(2)));

constexpr int SEQ = 8192, DM = 4096, PW = 16384, AW = 2048, NH = 16, HD = 128, BLK = 256, NB = 32;
constexpr int COL_Q = 0, COL_K = 2048, COL_V = 4096, COL_ZA = 6144, COL_HC = 8192, COL_BG = 10240, COL_CG = 12288, COL_ZC = 14336;
constexpr float EPS = 1e-6f;
constexpr float LOG2E = 1.4426950408889634f;
constexpr float QK_C = 0.08838834764831845f * LOG2E;

__device__ __forceinline__ unsigned cvtpk(float lo, float hi) { f32x2_t v = {lo, hi}; bf16x2_t b = __builtin_convertvector(v, bf16x2_t); return __builtin_bit_cast(unsigned, b); }
__device__ __forceinline__ float bf_lo(unsigned w) { return __uint_as_float(w << 16); }
__device__ __forceinline__ float bf_hi(unsigned w) { return __uint_as_float(w & 0xffff0000u); }
__device__ __forceinline__ float silu_f(float z) { return z / (1.f + __expf(-z)); }
__device__ __forceinline__ int hw_lane() { int l; asm volatile("v_mbcnt_lo_u32_b32 %0, -1, 0\n\tv_mbcnt_hi_u32_b32 %0, -1, %0" : "=v"(l)); return l; }
__device__ __forceinline__ int crow(int r, int hi) { return (r & 3) + 8 * (r >> 2) + 4 * hi; }

namespace pg8 {
#define PG8_LAS __attribute__((address_space(3)))
__device__ __forceinline__ void glds16s(const void* sbase, unsigned voff, unsigned lds_dst) {
    unsigned keep;
    asm volatile("s_mov_b32 %0, m0\n\ts_mov_b32 m0, %3\n\ts_nop 0\n\tglobal_load_lds_dwordx4 %1, %2\n\ts_mov_b32 m0, %0" : "=&s"(keep) : "v"(voff), "s"(sbase), "s"(lds_dst) : "memory");
}
constexpr int BM = 256, BK = 64, HALF = 128, HTB = HALF * BK * 2, STAGE_BYTES = 8 * HTB, NXCD = 8, WGM = 8;
__host__ __device__ __forceinline__ int lds_byte(int r, int c) { const int st = (r >> 4) * 2 + (c >> 5), rr = r & 15, cc = c & 31, ob = rr * 64 + cc * 2; return st * 1024 + (ob ^ (((ob >> 9) & 1) << 5)); }
__host__ __device__ __forceinline__ void stage_rc(int b, int& R, int& C) { const int st = b / 1024, sb = b % 1024, swz = sb ^ (((sb >> 9) & 1) << 5); R = (st >> 1) * 16 + swz / 64; C = (st & 1) * 32 + (swz % 64) / 2; }
__host__ __device__ __forceinline__ int perm32(int rho) { const int n = rho >> 4, i = rho & 15; return 8 * (i >> 2) + 4 * n + (i & 3); }

struct Unit { int pm, pn; };
struct Gemm { const void* A; const void* Bt; int M, N, K; };

struct StaticOrder {
    int nM, nN, nwg, G, c, skip_from, skip_by;
    __host__ __device__ void init(int M, int N, int G_, int c_, int sf = 1 << 30, int sb = 0) { nM = M / BM; nN = N / BM; nwg = nM * nN; G = G_; c = c_; skip_from = sf; skip_by = sb; }
    __host__ __device__ bool next(int i, Unit& u) const {
        const long L = (long)i * G + c; if (L >= nwg) return false;
        int wgid = (int)L; { const int q = nwg / NXCD, r = nwg % NXCD, xcd = wgid % NXCD, off = wgid / NXCD; wgid = (xcd < r ? xcd * (q + 1) : r * (q + 1) + (xcd - r) * q) + off; }
        const int nig = WGM * nN, gid = wgid / nig, fm = gid * WGM, gsz = (nM - fm) < WGM ? (nM - fm) : WGM;
        u.pm = fm + ((wgid % nig) % gsz); u.pn = (wgid % nig) / gsz; if (u.pn >= skip_from) u.pn += skip_by; return true;
    }
    __device__ __forceinline__ void a_ready(const Unit&) const {}
    __device__ __forceinline__ void done(const Unit&) const {}
};

struct EpiProj {
    static constexpr bool PERM = true, AFTER_DRAIN = false;
    bf16_t* O; int ldc; float* ksum;
    __device__ __forceinline__ void operator()(const f32x4 (&acc)[2][2][4][2], const Unit& u, int wr, int wc, int fr, int fq) const {
        const int row0 = u.pm * BM + wr * 64 + fr; const int col0 = u.pn * BM + wc * 32 + 8 * fq;
#pragma unroll
        for (int ai = 0; ai < 2; ++ai)
#pragma unroll
            for (int m = 0; m < 4; ++m) { bf16_t* rowp = O + (size_t)(row0 + ai * HALF + m * 16) * ldc + col0;
#pragma unroll
                for (int bj = 0; bj < 2; ++bj) { const f32x4 v0 = acc[ai][bj][m][0], v1 = acc[ai][bj][m][1];
                    u32x4 w; w.x = cvtpk(v0[0], v0[1]); w.y = cvtpk(v0[2], v0[3]); w.z = cvtpk(v1[0], v1[1]); w.w = cvtpk(v1[2], v1[3]);
                    *(u32x4*)(rowp + bj * HALF) = w; } }
        if (ksum && u.pn >= 8 && u.pn < 16) {
            float* kp = ksum + (size_t)u.pm * 2048 + (u.pn - 8) * BM + wc * 32 + 8 * fq;
#pragma unroll
            for (int bj = 0; bj < 2; ++bj)
#pragma unroll
                for (int n = 0; n < 2; ++n) {
                    f32x4 s = acc[0][bj][0][n];
#pragma unroll
                    for (int m = 1; m < 4; ++m) s += acc[0][bj][m][n];
#pragma unroll
                    for (int m = 0; m < 4; ++m) s += acc[1][bj][m][n];
#pragma unroll
                    for (int j = 0; j < 4; ++j) { float v = s[j]; v += __shfl_xor(v, 1); v += __shfl_xor(v, 2); v += __shfl_xor(v, 4); v += __shfl_xor(v, 8);
                        if (fr == 0) atomicAdd(kp + bj * HALF + 4 * n + j, v); }
                }
        }
    }
};
struct EpiOut {
    static constexpr bool PERM = false, AFTER_DRAIN = false;
    const float* X; float* out; float* rowss;
    __device__ __forceinline__ void operator()(const f32x4 (&acc)[2][2][4][2], const Unit& u, int wr, int wc, int fr, int fq) const {
        const int col0 = u.pn * BM + wc * 32 + 4 * fq;
#pragma unroll
        for (int ai = 0; ai < 2; ++ai)
#pragma unroll
            for (int m = 0; m < 4; ++m) { const int row = u.pm * BM + ai * HALF + wr * 64 + m * 16 + fr; const size_t off = (size_t)row * DM + col0; float ss = 0.f;
#pragma unroll
                for (int bj = 0; bj < 2; ++bj)
#pragma unroll
                    for (int n = 0; n < 2; ++n) { const f32x4 xv = *(const f32x4*)(X + off + bj * HALF + n * 16); const f32x4 hv = xv + acc[ai][bj][m][n];
                        *(f32x4*)(out + off + bj * HALF + n * 16) = hv; ss += (hv[0] * hv[0] + hv[1] * hv[1]) + (hv[2] * hv[2] + hv[3] * hv[3]); }
                ss += __shfl_xor(ss, 16); ss += __shfl_xor(ss, 32);
                if (fq == 0) rowss[(size_t)row * 64 + u.pn * 4 + wc] = ss; }
    }
};

constexpr int F8_SCALE_W = 0x78787878, F8_SCALE_U = 0x7D7D7D7D;
typedef int v4i_t __attribute__((ext_vector_type(4)));
typedef int v8i_t __attribute__((ext_vector_type(8)));
template <class Epi, class Sched, bool ALIGN_EPI = false, bool SP2 = false, bool F8 = false>
__device__ __forceinline__ void gemm_phase(PG8_LAS unsigned char* lds, const Gemm g, const Sched& S, const Epi& E, int wid) {
    const int lane = hw_lane(), tid = wid * 64 + lane, wr = wid >> 2, wc = wid & 3, fr = lane & 15, fq = lane >> 4;
    const int pitch = g.K * (F8 ? 1 : 2), nt = pitch / 128;
    unsigned voffA[2], voffB[2];
#pragma unroll
    for (int i = 0; i < 2; ++i) { int R, C; stage_rc(tid * 16 + i * 8192, R, C); const int Rb = Epi::PERM ? ((R & ~31) + perm32(R & 31)) : R;
        voffA[i] = (unsigned)(R * pitch + C * 2); voffB[i] = (unsigned)(Rb * pitch + C * 2); }
    const size_t kstep = (size_t)(BK * 2);
    const size_t hstep = (size_t)HALF * pitch;
    const size_t tstep = 2 * hstep;
    const unsigned ldsb = (unsigned)__builtin_amdgcn_readfirstlane((int)((unsigned)(uintptr_t)lds + (unsigned)wid * 1024u));
    const int aoff = lds_byte(wr * 64 + fr, fq * 8), boff = lds_byte(wc * 32 + fr, fq * 8);
#define PG8_SA(b, h) (((b) * 2 + (h)) * HTB)
#define PG8_SB(b, h) ((4 + (b) * 2 + (h)) * HTB)
#define PG8_STAGE(bufoff, gbase, voff) do { _Pragma("unroll") for (int _i = 0; _i < 2; ++_i) \
        glds16s((const void*)(gbase), (voff)[_i], ldsb + (unsigned)((bufoff) + _i * 8192)); } while (0)
#define PG8_LDA(dst, b, h) do { _Pragma("unroll") for (int m = 0; m < 4; ++m) _Pragma("unroll") for (int k = 0; k < 2; ++k) dst[m][k] = *(const PG8_LAS bf16x8*)(lds + PG8_SA(b, h) + aoff + m * 2048 + k * 1024); } while (0)
#define PG8_LDB(dst, b, h) do { _Pragma("unroll") for (int n = 0; n < 2; ++n) _Pragma("unroll") for (int k = 0; k < 2; ++k) dst[n][k] = *(const PG8_LAS bf16x8*)(lds + PG8_SB(b, h) + boff + n * 2048 + k * 1024); } while (0)
#define PG8_MMA(ai, bj, At, Bt) do { __builtin_amdgcn_s_setprio(1); _Pragma("unroll") for (int m = 0; m < 4; ++m) _Pragma("unroll") for (int n = 0; n < 2; ++n) _Pragma("unroll") for (int k = 0; k < 2; ++k) \
        acc[ai][bj][m][n] = __builtin_amdgcn_mfma_f32_16x16x32_bf16(Bt[n][k], At[m][k], acc[ai][bj][m][n], 0, 0, 0); __builtin_amdgcn_s_setprio(0); } while (0)
#define PG8_CAT(x0, x1) __builtin_shufflevector(__builtin_bit_cast(v4i_t, x0), __builtin_bit_cast(v4i_t, x1), 0, 1, 2, 3, 4, 5, 6, 7)
#define PG8_MMA8(ai, bj, At, Bt) do { __builtin_amdgcn_s_setprio(1); _Pragma("unroll") for (int m = 0; m < 4; ++m) _Pragma("unroll") for (int n = 0; n < 2; ++n) \
        acc[ai][bj][m][n] = __builtin_amdgcn_mfma_scale_f32_16x16x128_f8f6f4(PG8_CAT(Bt[n][0], Bt[n][1]), PG8_CAT(At[m][0], At[m][1]), acc[ai][bj][m][n], 0, 0, 0, F8_SCALE_W, 0, F8_SCALE_U); __builtin_amdgcn_s_setprio(0); } while (0)
#define PG8_MM(ai, bj, At, Bt) do { if constexpr (F8) PG8_MMA8(ai, bj, At, Bt); else PG8_MMA(ai, bj, At, Bt); } while (0)
#define PG8_WAIT_V(n) asm volatile("s_waitcnt vmcnt(" #n ")" ::: "memory")
#define PG8_WAIT_L(n) asm volatile("s_waitcnt lgkmcnt(" #n ")" ::: "memory")
#define PG8_BAR __builtin_amdgcn_s_barrier()
#define PG8_SCHED __builtin_amdgcn_sched_barrier(0)
    Unit cur, nxt; int ui = 0;
    if (!S.next(0, cur)) return;
    f32x4 acc[2][2][4][2];
#pragma unroll
    for (int a = 0; a < 2; ++a)
#pragma unroll
        for (int b = 0; b < 2; ++b)
#pragma unroll
            for (int m = 0; m < 4; ++m)
#pragma unroll
                for (int n = 0; n < 2; ++n) acc[a][b][m][n] = (f32x4){0.f, 0.f, 0.f, 0.f};
    bf16x8 At[4][2], B0[2][2], B1[2][2];
    const char* cA = (const char*)g.A + (size_t)cur.pm * tstep; const char* cB = (const char*)g.Bt + (size_t)cur.pn * tstep;
    S.a_ready(cur);
    if constexpr (SP2) {
        PG8_STAGE(PG8_SB(0, 0), cB, voffB); PG8_STAGE(PG8_SB(0, 1), cB + hstep, voffB); PG8_STAGE(PG8_SA(0, 0), cA, voffA); PG8_STAGE(PG8_SA(0, 1), cA + hstep, voffA);
        if (wr == 1) PG8_BAR;
        PG8_WAIT_V(2); PG8_BAR;
        PG8_STAGE(PG8_SB(1, 0), cB + kstep, voffB); PG8_STAGE(PG8_SA(1, 0), cA + kstep, voffA); PG8_STAGE(PG8_SB(1, 1), cB + hstep + kstep, voffB);
        PG8_WAIT_V(6); PG8_BAR;
    } else {
        PG8_STAGE(PG8_SB(0, 0), cB, voffB); PG8_STAGE(PG8_SA(0, 0), cA, voffA); PG8_STAGE(PG8_SB(0, 1), cB + hstep, voffB); PG8_STAGE(PG8_SA(0, 1), cA + hstep, voffA);
        if (wr == 1) PG8_BAR;
        PG8_WAIT_V(4); PG8_BAR;
        PG8_STAGE(PG8_SB(1, 0), cB + kstep, voffB); PG8_STAGE(PG8_SA(1, 0), cA + kstep, voffA); PG8_STAGE(PG8_SB(1, 1), cB + hstep + kstep, voffB);
        PG8_WAIT_V(6); PG8_BAR;
    }
    for (;;) {
        const bool has_next = S.next(ui + 1, nxt);
        const char* nA = has_next ? (const char*)g.A + (size_t)nxt.pm * tstep : cA; const char* nB = has_next ? (const char*)g.Bt + (size_t)nxt.pn * tstep : cB;
        for (int t = 0; t < nt; t += 2) {
            const bool last = (t == nt - 2);
            const char* a1 = cA + (size_t)(t + 1) * kstep;
            const char* a2 = last ? nA : cA + (size_t)(t + 2) * kstep; const char* b2 = last ? nB : cB + (size_t)(t + 2) * kstep;
            const char* a3 = a2 + kstep; const char* b3 = b2 + kstep;
            if (last && has_next) S.a_ready(nxt);
            if constexpr (SP2) {
            PG8_LDB(B0, 0, 0); PG8_LDB(B1, 0, 1); PG8_SCHED; PG8_LDA(At, 0, 0); PG8_STAGE(PG8_SA(1, 1), a1 + hstep, voffA);
            PG8_WAIT_V(8); PG8_WAIT_L(0); PG8_BAR; PG8_MM(0, 0, At, B0); PG8_MM(0, 1, At, B1); PG8_BAR; PG8_SCHED;
            PG8_LDA(At, 0, 1); PG8_STAGE(PG8_SB(0, 0), b2, voffB); PG8_STAGE(PG8_SB(0, 1), b2 + hstep, voffB); PG8_STAGE(PG8_SA(0, 0), a2, voffA);
            PG8_WAIT_V(8); PG8_WAIT_L(0); PG8_BAR; PG8_MM(1, 0, At, B0); PG8_MM(1, 1, At, B1); PG8_BAR; PG8_SCHED;
            PG8_LDB(B0, 1, 0); PG8_LDB(B1, 1, 1); PG8_SCHED; PG8_LDA(At, 1, 0); PG8_STAGE(PG8_SA(0, 1), a2 + hstep, voffA);
            PG8_WAIT_V(8); PG8_WAIT_L(0); PG8_BAR; PG8_MM(0, 0, At, B0); PG8_MM(0, 1, At, B1); PG8_BAR; PG8_SCHED;
            PG8_LDA(At, 1, 1); PG8_STAGE(PG8_SB(1, 0), b3, voffB); PG8_STAGE(PG8_SB(1, 1), b3 + hstep, voffB); PG8_STAGE(PG8_SA(1, 0), a3, voffA);
            PG8_WAIT_V(8); PG8_WAIT_L(0); PG8_BAR; PG8_MM(1, 0, At, B0); PG8_MM(1, 1, At, B1); PG8_BAR; PG8_SCHED;
            } else {
            PG8_LDB(B0, 0, 0); PG8_SCHED; PG8_LDA(At, 0, 0); PG8_STAGE(PG8_SA(1, 1), a1 + hstep, voffA);
            PG8_WAIT_L(8); PG8_BAR; PG8_WAIT_L(0); PG8_MM(0, 0, At, B0); PG8_BAR; PG8_SCHED;
            PG8_LDB(B1, 0, 1); PG8_STAGE(PG8_SB(0, 0), b2, voffB);
            PG8_BAR; PG8_WAIT_L(0); PG8_MM(0, 1, At, B1); PG8_BAR;
            PG8_LDA(At, 0, 1); PG8_STAGE(PG8_SA(0, 0), a2, voffA);
            PG8_BAR; PG8_WAIT_L(0); PG8_MM(1, 0, At, B0); PG8_BAR; PG8_SCHED;
            PG8_STAGE(PG8_SB(0, 1), b2 + hstep, voffB);
            PG8_WAIT_V(6); PG8_BAR; PG8_MM(1, 1, At, B1); PG8_BAR;
            PG8_LDB(B0, 1, 0); PG8_SCHED; PG8_LDA(At, 1, 0); PG8_STAGE(PG8_SA(0, 1), a2 + hstep, voffA);
            PG8_WAIT_L(8); PG8_BAR; PG8_WAIT_L(0); PG8_MM(0, 0, At, B0); PG8_BAR; PG8_SCHED;
            PG8_LDB(B1, 1, 1); PG8_STAGE(PG8_SB(1, 0), b3, voffB);
            PG8_BAR; PG8_WAIT_L(0); PG8_MM(0, 1, At, B1); PG8_BAR;
            PG8_LDA(At, 1, 1); PG8_STAGE(PG8_SA(1, 0), a3, voffA);
            PG8_BAR; PG8_WAIT_L(0); PG8_MM(1, 0, At, B0); PG8_BAR; PG8_SCHED;
            PG8_STAGE(PG8_SB(1, 1), b3 + hstep, voffB);
            PG8_WAIT_V(6); PG8_BAR; PG8_MM(1, 1, At, B1); PG8_BAR;
            }
        }
        if constexpr (ALIGN_EPI) { if (wr == 0) PG8_BAR; }
        if constexpr (!Epi::AFTER_DRAIN) { E(acc, cur, wr, wc, fr, fq); S.done(cur); }
        if (!has_next) break;
#pragma unroll
        for (int a = 0; a < 2; ++a)
#pragma unroll
            for (int b = 0; b < 2; ++b)
#pragma unroll
                for (int m = 0; m < 4; ++m)
#pragma unroll
                    for (int n = 0; n < 2; ++n) acc[a][b][m][n] = (f32x4){0.f, 0.f, 0.f, 0.f};
        cur = nxt; cA = nA; cB = nB; ++ui;
        if constexpr (ALIGN_EPI) { if (wr == 1) PG8_BAR; }
    }
    PG8_WAIT_V(0);
    if constexpr (!ALIGN_EPI) { if (wr == 0) PG8_BAR; }
    PG8_BAR;
#undef PG8_SA
#undef PG8_SB
#undef PG8_STAGE
#undef PG8_LDA
#undef PG8_LDB
#undef PG8_MMA
#undef PG8_MMA8
#undef PG8_MM
#undef PG8_CAT
#undef PG8_WAIT_V
#undef PG8_WAIT_L
#undef PG8_BAR
#undef PG8_SCHED
}
}

constexpr int NWAVES = 8;
constexpr int N_LAUNCHES = MK_N_LAUNCHES;
constexpr int N_PHASES = 7;

constexpr size_t MiB = 1u << 20;
constexpr size_t WS_CTL = 0, CTL_ZERO_BYTES = 1 * MiB;
constexpr size_t WS_WIN = 2 * MiB;
constexpr size_t WS_WOUT = 130 * MiB;
constexpr size_t WS_U = 162 * MiB;
constexpr size_t WS_PROJ = 226 * MiB;
constexpr size_t WS_MIX = 482 * MiB;
constexpr size_t WS_PART = 546 * MiB;
constexpr size_t WS_LSE = 674 * MiB;
constexpr size_t WS_KSUM = 676 * MiB;
constexpr size_t WS_LIST = 677 * MiB;
constexpr size_t WS_CNT = 685 * MiB;
constexpr size_t WS_ROWSS = 686 * MiB;
constexpr size_t WS_W8 = 688 * MiB;
constexpr size_t WS_U8 = 704 * MiB;
constexpr size_t WS_END = 736 * MiB;
constexpr int CW_BAR = 4096;
constexpr int CW_ITEM = 64;

constexpr int RING_BYTES = 131072;
constexpr int LDSCTL_OFF = RING_BYTES, MISC_OFF = LDSCTL_OFF + 320;
constexpr int ATT_LUT_OFF = RING_BYTES + 1024;
constexpr int ATT_MISC_OFF = ATT_LUT_OFF + 3072;
constexpr int LDS_BYTES = 147456;

typedef GAS unsigned gu32;
#define RLX_AGENT __ATOMIC_RELAXED, __HIP_MEMORY_SCOPE_AGENT
#define LDS_WAIT() asm volatile("s_waitcnt lgkmcnt(0)" ::: "memory")
#define VM_WAIT() asm volatile("s_waitcnt vmcnt(0)" ::: "memory")

#define XB_TMO      128
#define XB_XCNT(j)  (256  + 64 * (j))
#define XB_XSUB(j)  (1280 + 64 * (j))
#define XB_XGEN(j)  (2304 + 64 * (j))
#define XB_TOP      3328
#define XB_TOPGEN   3392
#define XCD_BAR_WORDS 3456
#define XB_SPIN_CAP (1u << 20)
__device__ __forceinline__ unsigned xb_ld(unsigned* p)              { return __hip_atomic_load(p, __ATOMIC_RELAXED, __HIP_MEMORY_SCOPE_AGENT); }
__device__ __forceinline__ unsigned xb_add(unsigned* p, unsigned v) { return __hip_atomic_fetch_add(p, v, __ATOMIC_RELAXED, __HIP_MEMORY_SCOPE_AGENT); }
__device__ __forceinline__ unsigned xb_xcc_id() { return (unsigned)__builtin_amdgcn_s_getreg((3 << 11) | 20) & 0xFu; }
#define XB_SPIN(cond, bar) do { unsigned _sp = 0; while (cond) { __builtin_amdgcn_s_sleep(1); \
    if ((++_sp & 255u) == 0u) { if (xb_ld(&(bar)[XB_TMO])) break; if (_sp > XB_SPIN_CAP) { atomicAdd(&(bar)[XB_TMO], 1u); break; } } } } while (0)
struct XcdBarrier { unsigned* bar; unsigned x; volatile LAS unsigned* st; };
__device__ __forceinline__ XcdBarrier xcd_barrier_post(unsigned* bar, volatile LAS unsigned* st) {
    XcdBarrier b; b.bar = bar; b.x = xb_xcc_id(); b.st = st;
    if (threadIdx.x == 0) (void)xb_add(&bar[XB_XCNT(b.x)], 1u);
    return b;
}
__device__ __forceinline__ void xcd_barrier_complete(unsigned* bar, unsigned x, unsigned& nloc, unsigned& nx) {
    const unsigned G = gridDim.x * gridDim.y * gridDim.z;
    unsigned sum, cnt, mine, sp = 0u;
    for (;;) {
        sum = 0u; cnt = 0u; mine = 0u;
#pragma unroll
        for (unsigned j = 0; j < 16; ++j) { const unsigned c = xb_ld(&bar[XB_XCNT(j)]); sum += c; cnt += (c > 0u) ? 1u : 0u; mine = (j == x) ? c : mine; }
        if (sum == G) break;
        __builtin_amdgcn_s_sleep(1);
        if ((++sp & 255u) == 0u) { if (xb_ld(&bar[XB_TMO])) break; if (sp > XB_SPIN_CAP) { atomicAdd(&bar[XB_TMO], 1u); break; } }
    }
    nloc = mine > 0u ? mine : 1u; nx = cnt > 0u ? cnt : 1u;
}
__device__ __forceinline__ void xcd_barrier(const XcdBarrier& b) {
    asm volatile("s_waitcnt vmcnt(0)" ::: "memory");
    __syncthreads();
    if (threadIdx.x == 0) {
        unsigned* bar = b.bar;
        __builtin_amdgcn_s_waitcnt(0);
        unsigned nloc = b.st[0], nx = b.st[1];
        if (nloc == 0u) { xcd_barrier_complete(bar, b.x, nloc, nx); b.st[0] = nloc; b.st[1] = nx; }
        const unsigned old = xb_add(&bar[XB_XSUB(b.x)], 1u);
        const unsigned gen = old / nloc;
        if (old + 1u == (gen + 1u) * nloc) {
            __builtin_amdgcn_fence(__ATOMIC_RELEASE, "agent");
            asm volatile("s_waitcnt vmcnt(0)" ::: "memory");
            const unsigned og = xb_add(&bar[XB_TOP], 1u);
            const unsigned tg = og / nx;
            if (og + 1u == (tg + 1u) * nx) xb_add(&bar[XB_TOPGEN], 1u);
            else XB_SPIN(xb_ld(&bar[XB_TOPGEN]) == tg, bar);
            __builtin_amdgcn_fence(__ATOMIC_ACQUIRE, "agent");
            xb_add(&bar[XB_XGEN(b.x)], 1u);
            asm volatile("s_waitcnt vmcnt(0)" ::: "memory");
        } else {
            XB_SPIN(xb_ld(&bar[XB_XGEN(b.x)]) == gen, bar);
            __builtin_amdgcn_fence(__ATOMIC_ACQUIRE, "agent");
            asm volatile("s_waitcnt vmcnt(0)" ::: "memory");
        }
    }
    __syncthreads();
}

struct Frame {
    LAS unsigned char* lds;
    volatile LAS unsigned* MISC;
    unsigned* ctl;
    int wave, vcu, G;
    const float *x, *ng, *w_in, *conv_w, *w_out, *rel_bias, *fg; float* out;
    bf16_t *WinT, *WoutT, *U, *PROJ, *MIX, *PART; unsigned char *W8, *U8; float *LSE, *KSUM, *ROWSS; unsigned short* LIST; int* CNT;
};

__device__ __forceinline__ float wave_sum(float v) {
#pragma unroll
    for (int o = 1; o < 64; o <<= 1) v += __shfl_xor(v, o);
    return v;
}

__device__ __forceinline__ void p0_tile_load(f32x4 (&v)[8], const float* W, int N, int kb, int nb, int wave, int lane) {
    const float* src = W + (size_t)(64 * kb + 8 * wave) * N + 256 * nb + 4 * lane;
#pragma unroll
    for (int i = 0; i < 8; ++i) v[i] = *(const f32x4*)(src + (size_t)i * N);
}
__device__ __forceinline__ void p0_tile_store(const f32x4 (&v)[8], bf16_t* WT, int kb, int nb, LAS unsigned* T, int tid, int wave, int lane) {
#pragma unroll
    for (int ii = 0; ii < 4; ++ii) { const int kp = 4 * wave + ii; u32x4 d;
        d.x = cvtpk(v[2 * ii][0], v[2 * ii + 1][0]); d.y = cvtpk(v[2 * ii][1], v[2 * ii + 1][1]); d.z = cvtpk(v[2 * ii][2], v[2 * ii + 1][2]); d.w = cvtpk(v[2 * ii][3], v[2 * ii + 1][3]);
        *(LAS u32x4*)(T + kp * 256 + ((4 * lane) ^ (wave << 2))) = d; }
    LDS_WAIT(); __syncthreads();
#pragma unroll
    for (int i = 0; i < 4; ++i) { const int idx = tid + 512 * i, n = idx >> 3, c = idx & 7; u32x4 o;
        const LAS unsigned* tp = T + (4 * c) * 256 + (n ^ (c << 2));
        o.x = tp[0]; o.y = tp[256]; o.z = tp[512]; o.w = tp[768];
        *(u32x4*)(WT + (size_t)(256 * nb + n) * 4096 + 64 * kb + 8 * c) = o; }
    LDS_WAIT(); __syncthreads();
}
__device__ __forceinline__ void p0_tile_store_f8(const f32x4 (&v)[8], unsigned char* W8, int kb, int nb8, LAS unsigned* T, int tid, int wave, int lane) {
#pragma unroll
    for (int q2 = 0; q2 < 2; ++q2) { const int kq = 2 * wave + q2; u32x4 d;
#pragma unroll
        for (int c = 0; c < 4; ++c) { int w32 = __builtin_amdgcn_cvt_pk_fp8_f32(v[4 * q2][c] * 128.f, v[4 * q2 + 1][c] * 128.f, 0, false); w32 = __builtin_amdgcn_cvt_pk_fp8_f32(v[4 * q2 + 2][c] * 128.f, v[4 * q2 + 3][c] * 128.f, w32, true); d[c] = (unsigned)w32; }
        *(LAS u32x4*)(T + kq * 256 + ((4 * lane) ^ (((kq >> 2) & 3) << 3))) = d; }
    LDS_WAIT(); __syncthreads();
#pragma unroll
    for (int i = 0; i < 2; ++i) { const int idx = tid + 512 * i, n = idx >> 2, c = idx & 3; u32x4 o;
        const LAS unsigned* tp = T + (4 * c) * 256 + (n ^ (c << 3));
        o.x = tp[0]; o.y = tp[256]; o.z = tp[512]; o.w = tp[768];
        *(u32x4*)(W8 + (size_t)(256 * nb8 + n) * 4096 + 64 * kb + 16 * c) = o; }
    LDS_WAIT(); __syncthreads();
}
__device__ __forceinline__ void p0_decode(int it, const float* w_in, const float* w_out, bf16_t* WinT, bf16_t* WoutT, const float*& W, int& N, bf16_t*& WT, int& kb, int& nb) {
    if (it < 4096) { W = w_in; N = PW; WT = WinT; nb = it & 63; kb = it >> 6; }
    else { const int r = it - 4096; W = w_out; N = DM; WT = WoutT; nb = r & 15; kb = r >> 4; }
}
__device__ __forceinline__ void p0_tile_out(const f32x4 (&v)[8], Frame& F, bf16_t* WT, int kb, int nb, LAS unsigned* T, int tid, int lane) {
    if (WT == F.WinT && nb >= 16 && nb < 32) p0_tile_store_f8(v, F.W8, kb, nb - 16, T, tid, F.wave, lane);
    else p0_tile_store(v, WT, kb, nb, T, tid, F.wave, lane);
}
__device__ __forceinline__ void p0_prologue(Frame& F) {
    const int lane = hw_lane(), tid = F.wave * 64 + lane;
    { const int gt = F.vcu * 512 + tid, NT = F.G * 512; for (int i = gt; i < NB * 2048 / 4; i += NT) ((f32x4*)F.KSUM)[i] = (f32x4){0.f, 0.f, 0.f, 0.f}; }
    {
        LAS unsigned* T = (LAS unsigned*)F.lds;
        constexpr int NIT = 4096 + 1024;
        f32x4 va[8], vb[8]; const float* W; int N, kb, nb; bf16_t* WT;
        int it = F.vcu;
        if (it < NIT) { p0_decode(it, F.w_in, F.w_out, F.WinT, F.WoutT, W, N, WT, kb, nb); p0_tile_load(va, W, N, kb, nb, F.wave, lane); }
        while (it < NIT) {
            const float* W2; int N2, kb2, nb2; bf16_t* WT2; const int it2 = it + F.G;
            if (it2 < NIT) { p0_decode(it2, F.w_in, F.w_out, F.WinT, F.WoutT, W2, N2, WT2, kb2, nb2); p0_tile_load(vb, W2, N2, kb2, nb2, F.wave, lane); }
            p0_tile_out(va, F, WT, kb, nb, T, tid, lane);
            it = it2; if (it >= NIT) break;
            const int it3 = it + F.G;
            if (it3 < NIT) { p0_decode(it3, F.w_in, F.w_out, F.WinT, F.WoutT, W, N, WT, kb, nb); p0_tile_load(va, W, N, kb, nb, F.wave, lane); }
            p0_tile_out(vb, F, WT2, kb2, nb2, T, tid, lane);
            it = it3;
        }
    }
    {
        const int gw = F.vcu * NWAVES + F.wave, NGW = F.G * NWAVES;
        for (int row = gw; row < SEQ; row += NGW) {
            const f32x4* xr = (const f32x4*)(F.x + (size_t)row * DM) + lane; f32x4 v[16]; float ss = 0.f;
#pragma unroll
            for (int j = 0; j < 16; ++j) { v[j] = xr[64 * j]; ss += (v[j][0] * v[j][0] + v[j][1] * v[j][1]) + (v[j][2] * v[j][2] + v[j][3] * v[j][3]); }
            const float rstd = 1.0f / sqrtf(wave_sum(ss) * (1.f / DM) + EPS);
            const f32x4* gr = (const f32x4*)F.ng + lane; u32x2* o8 = (u32x2*)(F.U + (size_t)row * DM) + lane; unsigned* o4 = (unsigned*)(F.U8 + (size_t)row * DM) + lane;
#pragma unroll
            for (int j = 0; j < 16; ++j) { const f32x4 g = gr[64 * j]; const float u0 = v[j][0] * rstd * g[0], u1 = v[j][1] * rstd * g[1], u2 = v[j][2] * rstd * g[2], u3 = v[j][3] * rstd * g[3];
                u32x2 w; w.x = cvtpk(u0, u1); w.y = cvtpk(u2, u3); o8[64 * j] = w;
                int w8 = __builtin_amdgcn_cvt_pk_fp8_f32(u0 * 4.f, u1 * 4.f, 0, false); w8 = __builtin_amdgcn_cvt_pk_fp8_f32(u2 * 4.f, u3 * 4.f, w8, true); o4[64 * j] = (unsigned)w8; }
        }
    }
}

#define TOP_BETTER(v, i, w, k) ((v) > (w) || ((v) == (w) && (i) < (k)))
#define TOP_INSERT(v, i) do { if (TOP_BETTER(v, i, v0, i0)) { v2 = v1; i2 = i1; v1 = v0; i1 = i0; v0 = (v); i0 = (i); } \
    else if (TOP_BETTER(v, i, v1, i1)) { v2 = v1; i2 = i1; v1 = (v); i1 = (i); } else if (TOP_BETTER(v, i, v2, i2)) { v2 = (v); i2 = (i); } } while (0)
__device__ __forceinline__ void p2_route(Frame& F) {
    const int lane = hw_lane(), tid = F.wave * 64 + lane;
    LAS int* lcnt = (LAS int*)F.lds;
    const int r32 = lane & 31, hi = lane >> 5;
    for (int u = F.vcu; u < NH * (NB - 1); u += F.G) {
        const int h = u & 15, qb = 1 + (u >> 4);
        if (tid < 32) lcnt[tid] = 0;
        __syncthreads();
        bf16x8 khi[8], klo[8], q[8];
        const float* kp = F.KSUM + (size_t)r32 * 2048 + h * HD + 8 * hi;
        const int ql = 32 * F.wave + r32, s = qb * BLK + ql;
        const bf16_t* qp = F.PROJ + (size_t)s * PW + COL_Q + h * HD + 8 * hi;
#pragma unroll
        for (int st = 0; st < 8; ++st) {
            const f32x4 a = *(const f32x4*)(kp + 16 * st), b = *(const f32x4*)(kp + 16 * st + 4);
            float f[8] = {a[0], a[1], a[2], a[3], b[0], b[1], b[2], b[3]}; u32x4 wh, wl; unsigned hh[4], ll[4];
#pragma unroll
            for (int e = 0; e < 4; ++e) { const float x0 = f[2 * e] * (1.f / 256.f), x1 = f[2 * e + 1] * (1.f / 256.f); const unsigned w = cvtpk(x0, x1); hh[e] = w; ll[e] = cvtpk(x0 - bf_lo(w), x1 - bf_hi(w)); }
            wh = (u32x4){hh[0], hh[1], hh[2], hh[3]}; wl = (u32x4){ll[0], ll[1], ll[2], ll[3]};
            khi[st] = __builtin_bit_cast(bf16x8, wh); klo[st] = __builtin_bit_cast(bf16x8, wl);
            q[st] = *(const bf16x8*)(qp + 16 * st);
        }
        f32x16 acc; for (int r = 0; r < 16; ++r) acc[r] = 0.f;
#pragma unroll
        for (int st = 0; st < 8; ++st) { acc = __builtin_amdgcn_mfma_f32_32x32x16_bf16(khi[st], q[st], acc, 0, 0, 0); acc = __builtin_amdgcn_mfma_f32_32x32x16_bf16(klo[st], q[st], acc, 0, 0, 0); }
        float v0 = -INFINITY, v1 = -INFINITY, v2 = -INFINITY; int i0 = 64, i1 = 65, i2 = 66;
#pragma unroll
        for (int r = 0; r < 16; ++r) { const int blk = crow(r, hi); const float v = (blk < qb) ? acc[r] : -INFINITY; TOP_INSERT(v, blk); }
        { const float p0 = __shfl_xor(v0, 32), p1 = __shfl_xor(v1, 32), p2 = __shfl_xor(v2, 32); const int j0 = __shfl_xor(i0, 32), j1 = __shfl_xor(i1, 32), j2 = __shfl_xor(i2, 32);
          TOP_INSERT(p0, j0); TOP_INSERT(p1, j1); TOP_INSERT(p2, j2); }
        const int nv = qb < 3 ? qb : 3;
        if (hi == 0) {
            const int sel[3] = {i0, i1, i2};
#pragma unroll
            for (int r = 0; r < 3; ++r) if (r < nv) { const int n = sel[r]; const int pos = __hip_atomic_fetch_add(lcnt + n, 1, __ATOMIC_RELAXED, __HIP_MEMORY_SCOPE_WORKGROUP);
                F.LIST[(((size_t)h * NB + n) * NB + qb) * BLK + pos] = (unsigned short)(ql | (r << 8)); }
        }
        LDS_WAIT(); __syncthreads();
        if (tid < qb) F.CNT[((size_t)h * NB + tid) * NB + qb] = lcnt[tid];
        __syncthreads();
    }
}

constexpr int N_ITEMS_PER_HEAD = 95;
__device__ __forceinline__ void item_decode(int e, int& j, int& lo, int& hq, int& own) {
    constexpr int ARB[8] = {1, 3, 5, 8, 12, 17, 24, 32};
    constexpr int CUM[8] = {0, 2, 6, 13, 24, 40, 63, 94};
    j = 31; lo = 32; hq = 32; own = 1;
#pragma unroll
    for (int ri = 0; ri < 7; ++ri) if (e >= CUM[ri] && e < CUM[ri + 1]) { j = e - CUM[ri]; lo = ARB[ri] > j + 1 ? ARB[ri] : j + 1; hq = ARB[ri + 1]; own = (ri == 0 || ARB[ri] <= j + 1) ? 1 : 0; }
}

template <bool GENERAL>
__device__ __forceinline__ void att_tile(const LAS unsigned char* Kl, const LAS unsigned char* Vl, const LAS float* lutp, float c31, int nkt,
                                         const bf16x8 (&qr)[8], int r32, int hi, int lane, float& m_out, float& l_out, f32x16 (&o)[4]) {
    float m = -1e30f, l = 0.f;
#pragma unroll
    for (int d0 = 0; d0 < 4; ++d0) for (int r = 0; r < 16; ++r) o[d0][r] = 0.f;
    const int X = (r32 & 15) << 4;
    const int i16 = lane & 15, qq = i16 >> 2, pp = i16 & 3, blk = (lane >> 4) & 1;
    int vb[4];
#pragma unroll
    for (int d0 = 0; d0 < 4; ++d0) vb[d0] = 256 * (4 * hi + qq) + 16 * (4 * (d0 ^ qq) + 2 * blk + (pp >> 1)) + 8 * (pp & 1);
    for (int kt = 0; kt < nkt; ++kt) {
        f32x16 p0, p1;
#pragma unroll
        for (int r = 0; r < 16; ++r) { p0[r] = 0.f; p1[r] = 0.f; }
        const LAS unsigned char* kr = Kl + 256 * (64 * kt + r32);
#pragma unroll
        for (int st = 0; st < 8; ++st) {
            const int cb = (32 * st + 16 * hi) ^ X;
            const bf16x8 a0 = *(const LAS bf16x8*)(kr + cb), a1 = *(const LAS bf16x8*)(kr + 32 * 256 + cb);
            p0 = __builtin_amdgcn_mfma_f32_32x32x16_bf16(a0, qr[st], p0, 0, 0, 0);
            p1 = __builtin_amdgcn_mfma_f32_32x32x16_bf16(a1, qr[st], p1, 0, 0, 0);
        }
        if (GENERAL) {
            const LAS float* lp = lutp - 64 * kt;
#pragma unroll
            for (int r = 0; r < 16; ++r) { const int kk = (r & 3) + 8 * (r >> 2); p0[r] = fmaf(p0[r], QK_C, lp[-kk]); p1[r] = fmaf(p1[r], QK_C, lp[-kk - 32]); }
        } else {
#pragma unroll
            for (int r = 0; r < 16; ++r) { p0[r] = fmaf(p0[r], QK_C, c31); p1[r] = fmaf(p1[r], QK_C, c31); }
        }
        float pmax = fmaxf(p0[0], p1[0]);
#pragma unroll
        for (int r = 1; r < 16; ++r) pmax = fmaxf(pmax, fmaxf(p0[r], p1[r]));
        { auto rr = __builtin_amdgcn_permlane32_swap(__float_as_uint(pmax), __float_as_uint(pmax), false, false); pmax = fmaxf(__uint_as_float(rr[0]), __uint_as_float(rr[1])); }
        const float mn = fmaxf(m, pmax);
        if (__any(mn > m)) {
            const float alpha = __builtin_amdgcn_exp2f(m - mn);
            l *= alpha;
#pragma unroll
            for (int d0 = 0; d0 < 4; ++d0) for (int r = 0; r < 16; ++r) o[d0][r] *= alpha;
            m = mn;
        }
        float ps = 0.f;
#pragma unroll
        for (int r = 0; r < 16; ++r) { p0[r] = __builtin_amdgcn_exp2f(p0[r] - m); p1[r] = __builtin_amdgcn_exp2f(p1[r] - m); ps += p0[r] + p1[r]; }
        l += ps;
        bf16x8 pb[4];
#pragma unroll
        for (int s2 = 0; s2 < 2; ++s2) {
            u32x4 w0 = {cvtpk(p0[8 * s2], p0[8 * s2 + 1]), cvtpk(p0[8 * s2 + 2], p0[8 * s2 + 3]), cvtpk(p0[8 * s2 + 4], p0[8 * s2 + 5]), cvtpk(p0[8 * s2 + 6], p0[8 * s2 + 7])};
            u32x4 w1 = {cvtpk(p1[8 * s2], p1[8 * s2 + 1]), cvtpk(p1[8 * s2 + 2], p1[8 * s2 + 3]), cvtpk(p1[8 * s2 + 4], p1[8 * s2 + 5]), cvtpk(p1[8 * s2 + 6], p1[8 * s2 + 7])};
            pb[s2] = __builtin_bit_cast(bf16x8, w0); pb[2 + s2] = __builtin_bit_cast(bf16x8, w1);
        }
        const LAS unsigned char* vt = Vl + 256 * 64 * kt;
#pragma unroll
        for (int d0 = 0; d0 < 4; ++d0)
#pragma unroll
            for (int ks = 0; ks < 4; ++ks) {
                const LAS unsigned char* vp = vt + vb[d0] + 256 * 16 * ks;
                const s16x4 lo4 = __builtin_bit_cast(s16x4, __builtin_amdgcn_ds_read_tr16_b64_v4i16((LAS s16x4*)(vp)));
                const s16x4 hi4 = __builtin_bit_cast(s16x4, __builtin_amdgcn_ds_read_tr16_b64_v4i16((LAS s16x4*)(vp + 256 * 8)));
                const bf16x8 va = __builtin_shufflevector(lo4, hi4, 0, 1, 2, 3, 4, 5, 6, 7);
                o[d0] = __builtin_amdgcn_mfma_f32_32x32x16_bf16(va, pb[ks], o[d0], 0, 0, 0);
            }
    }
    m_out = m; l_out = l;
}

__device__ __forceinline__ void p3_attention(Frame& F, int cw_item) {
    const int lane = hw_lane(), tid = F.wave * 64 + lane;
    LAS unsigned char* Kl = F.lds; LAS unsigned char* Vl = F.lds + 65536;
    LAS float* lut = (LAS float*)(F.lds + ATT_LUT_OFF);
    LAS int* misc = (LAS int*)(F.lds + ATT_MISC_OFF);
    const int r32 = lane & 31, hi = lane >> 5;
    const int NITEMS = N_ITEMS_PER_HEAD * NH;
    for (;;) {
        if (tid == 0) misc[0] = (int)__hip_atomic_fetch_add(F.ctl + cw_item, 1u, RLX_AGENT);
        LDS_WAIT(); __syncthreads();
        const int item = __builtin_amdgcn_readfirstlane(misc[0]);
        if (item >= NITEMS) break;
        const int h = item & 15, e = item >> 4;
        int j, lo, hq, own; item_decode(e, j, lo, hq, own);
        const int nsub = hq - lo;
        {
            const bf16_t* kg = F.PROJ + (size_t)(j * BLK) * PW + COL_K + h * HD; const bf16_t* vg = F.PROJ + (size_t)(j * BLK) * PW + COL_V + h * HD;
            u32x4 kv[8], vv[8];
#pragma unroll
            for (int i = 0; i < 8; ++i) { const int p = tid + 512 * i, row = p >> 4, ch = p & 15; kv[i] = *(const u32x4*)(kg + (size_t)row * PW + 8 * ch); vv[i] = *(const u32x4*)(vg + (size_t)row * PW + 8 * ch); }
#pragma unroll
            for (int i = 0; i < 8; ++i) { const int p = tid + 512 * i, row = p >> 4, ch = p & 15;
                *(LAS u32x4*)(Kl + 256 * row + ((16 * ch) ^ ((row & 15) << 4))) = kv[i];
                *(LAS u32x4*)(Vl + 256 * row + 16 * (ch ^ ((row & 3) << 2))) = vv[i]; }
        }
        for (int i = tid; i < 768; i += 512) {
            const int dist = i - 255; float v;
            if (dist < 0) v = -INFINITY;
            else { int b; if (dist < 16) b = dist; else { b = 16 + (int)(logf((float)dist * (1.f / 16.f)) / logf(8.f) * 16.f); b = b > 31 ? 31 : b; }
                   v = F.rel_bias[b * NH + h] * LOG2E; }
            lut[i] = v;
        }
        if (tid == 0) { int acc = own ? BLK : 0; misc[8] = acc; for (int k = 0; k < nsub; ++k) { acc += F.CNT[((size_t)h * NB + j) * NB + lo + k]; misc[9 + k] = acc; } }
        LDS_WAIT(); __syncthreads();
        const int nown = own ? BLK : 0;
        const int total = misc[8 + nsub];
        const float c31 = F.rel_bias[31 * NH + h] * LOG2E;
        const int NT = (total + 31) >> 5;
        for (int t = F.wave; t < NT; t += NWAVES) {
            const int e0 = 32 * t + r32; const bool valid = e0 < total; const int ee = valid ? e0 : total - 1;
            int qb, ql, slot;
            if (ee < nown) { qb = j; ql = ee; slot = 3; }
            else {
                int k = 0;
#pragma unroll
                for (int kk = 1; kk < 8; ++kk) if (kk < nsub && ee >= misc[8 + kk]) k = kk;
                qb = lo + k; const unsigned ent = F.LIST[(((size_t)h * NB + j) * NB + qb) * BLK + (ee - misc[8 + k])]; ql = ent & 255; slot = ent >> 8;
            }
            const int s = qb * BLK + ql; const int dbase = (qb - j) * BLK + ql; const int dbc = dbase < 511 ? dbase : 511;
            const bool own_tile = (32 * t) < nown;
            const int nkt = own_tile ? ((t >> 1) + 1) : 4;
            bf16x8 qr[8];
            const bf16_t* qp = F.PROJ + (size_t)s * PW + COL_Q + h * HD + 8 * hi;
#pragma unroll
            for (int st = 0; st < 8; ++st) qr[st] = *(const bf16x8*)(qp + 16 * st);
            f32x16 o[4]; float m, l;
            const bool general = !__all(dbase >= 368);
            if (general) att_tile<true>(Kl, Vl, lut + (dbc + 255 - 4 * hi), c31, nkt, qr, r32, hi, lane, m, l, o);
            else att_tile<false>(Kl, Vl, lut, c31, nkt, qr, r32, hi, lane, m, l, o);
            { auto rr = __builtin_amdgcn_permlane32_swap(__float_as_uint(l), __float_as_uint(l), false, false); l = __uint_as_float(rr[0]) + __uint_as_float(rr[1]); }
            const float inv = 1.0f / l;
            if (valid) {
                bf16_t* op = F.PART + (((size_t)s * NH + h) * 4 + slot) * HD + 4 * hi;
#pragma unroll
                for (int d0 = 0; d0 < 4; ++d0)
#pragma unroll
                    for (int g = 0; g < 4; ++g) { u32x2 w; w.x = cvtpk(o[d0][4 * g] * inv, o[d0][4 * g + 1] * inv); w.y = cvtpk(o[d0][4 * g + 2] * inv, o[d0][4 * g + 3] * inv); *(u32x2*)(op + 32 * d0 + 8 * g) = w; }
                if (hi == 0) F.LSE[((size_t)s * NH + h) * 4 + slot] = m + __log2f(l);
            }
        }
        __syncthreads();
    }
}

__device__ __forceinline__ void p4_mix(Frame& F) {
    const int lane = hw_lane(), tid = F.wave * 64 + lane;
    const int gt = F.vcu * 512 + tid, NT = F.G * 512;
    for (int idx = gt; idx < SEQ * NH * 16; idx += NT) {
        const int c = idx & 15, h = (idx >> 4) & 15, s = idx >> 8; const int qb = s >> 8, nv = qb < 3 ? qb : 3;
        const f32x4 L = *(const f32x4*)(F.LSE + ((size_t)s * NH + h) * 4);
        float M = L[3]; for (int r = 0; r < 3; ++r) if (r < nv) M = fmaxf(M, L[r]);
        float w[4]; float ws = 0.f;
        for (int r = 0; r < 3; ++r) { w[r] = (r < nv) ? __builtin_amdgcn_exp2f(L[r] - M) : 0.f; ws += w[r]; }
        w[3] = __builtin_amdgcn_exp2f(L[3] - M); ws += w[3];
        const float inv = 1.0f / ws;
        float acc[8] = {0.f, 0.f, 0.f, 0.f, 0.f, 0.f, 0.f, 0.f};
        const bf16_t* pp = F.PART + (((size_t)s * NH + h) * 4) * HD + 8 * c;
#pragma unroll
        for (int r = 0; r < 4; ++r) if (r == 3 || r < nv) { const u32x4 v = *(const u32x4*)(pp + r * HD); const float wr_ = w[r] * inv;
            acc[0] += wr_ * bf_lo(v.x); acc[1] += wr_ * bf_hi(v.x); acc[2] += wr_ * bf_lo(v.y); acc[3] += wr_ * bf_hi(v.y);
            acc[4] += wr_ * bf_lo(v.z); acc[5] += wr_ * bf_hi(v.z); acc[6] += wr_ * bf_lo(v.w); acc[7] += wr_ * bf_hi(v.w); }
        const u32x4 z = *(const u32x4*)(F.PROJ + (size_t)s * PW + COL_ZA + h * HD + 8 * c);
        u32x4 o;
        o.x = cvtpk(acc[0] * silu_f(bf_lo(z.x)), acc[1] * silu_f(bf_hi(z.x))); o.y = cvtpk(acc[2] * silu_f(bf_lo(z.y)), acc[3] * silu_f(bf_hi(z.y)));
        o.z = cvtpk(acc[4] * silu_f(bf_lo(z.z)), acc[5] * silu_f(bf_hi(z.z))); o.w = cvtpk(acc[6] * silu_f(bf_lo(z.w)), acc[7] * silu_f(bf_hi(z.w)));
        *(u32x4*)(F.MIX + (size_t)s * DM + h * HD + 8 * c) = o;
    }
    for (int idx = gt; idx < SEQ * 256; idx += NT) {
        const int c8 = idx & 255, s = idx >> 8, ch = 8 * c8;
        float t[3][8];
#pragma unroll
        for (int k = 0; k < 3; ++k) {
            const int sp = s - 2 + k;
            if (sp >= 0) { const u32x4 hv = *(const u32x4*)(F.PROJ + (size_t)sp * PW + COL_HC + ch), cv = *(const u32x4*)(F.PROJ + (size_t)sp * PW + COL_CG + ch);
                t[k][0] = bf_lo(hv.x) * bf_lo(cv.x); t[k][1] = bf_hi(hv.x) * bf_hi(cv.x); t[k][2] = bf_lo(hv.y) * bf_lo(cv.y); t[k][3] = bf_hi(hv.y) * bf_hi(cv.y);
                t[k][4] = bf_lo(hv.z) * bf_lo(cv.z); t[k][5] = bf_hi(hv.z) * bf_hi(cv.z); t[k][6] = bf_lo(hv.w) * bf_lo(cv.w); t[k][7] = bf_hi(hv.w) * bf_hi(cv.w); }
            else { for (int e = 0; e < 8; ++e) t[k][e] = 0.f; }
        }
        const u32x4 bv = *(const u32x4*)(F.PROJ + (size_t)s * PW + COL_BG + ch), zv = *(const u32x4*)(F.PROJ + (size_t)s * PW + COL_ZC + ch);
        const float bg[8] = {bf_lo(bv.x), bf_hi(bv.x), bf_lo(bv.y), bf_hi(bv.y), bf_lo(bv.z), bf_hi(bv.z), bf_lo(bv.w), bf_hi(bv.w)};
        const float zc[8] = {bf_lo(zv.x), bf_hi(zv.x), bf_lo(zv.y), bf_hi(zv.y), bf_lo(zv.z), bf_hi(zv.z), bf_lo(zv.w), bf_hi(zv.w)};
        float y[8];
#pragma unroll
        for (int e = 0; e < 8; ++e) { const float w0 = F.conv_w[ch + e], w1 = F.conv_w[2048 + ch + e], w2 = F.conv_w[4096 + ch + e];
            y[e] = bg[e] * (t[0][e] * w0 + t[1][e] * w1 + t[2][e] * w2) * silu_f(zc[e]); }
        u32x4 o; o.x = cvtpk(y[0], y[1]); o.y = cvtpk(y[2], y[3]); o.z = cvtpk(y[4], y[5]); o.w = cvtpk(y[6], y[7]);
        *(u32x4*)(F.MIX + (size_t)s * DM + AW + ch) = o;
    }
}

__device__ __forceinline__ void p6_final(Frame& F) {
    const int lane = hw_lane(), tid = F.wave * 64 + lane;
    const int gw = F.vcu * NWAVES + F.wave, NGW = F.G * NWAVES;
    for (int row = gw; row < SEQ; row += NGW) {
        const float ss = wave_sum(F.ROWSS[(size_t)row * 64 + lane]);
        const float rstd = 1.0f / sqrtf(ss * (1.f / DM) + EPS);
        f32x4* orow = (f32x4*)(F.out + (size_t)row * DM) + lane; const f32x4* gr = (const f32x4*)F.fg + lane;
        f32x4 v[16];
#pragma unroll
        for (int j = 0; j < 16; ++j) v[j] = orow[64 * j];
#pragma unroll
        for (int j = 0; j < 16; ++j) { const f32x4 g = gr[64 * j]; f32x4 r; r[0] = v[j][0] * rstd * g[0]; r[1] = v[j][1] * rstd * g[1]; r[2] = v[j][2] * rstd * g[2]; r[3] = v[j][3] * rstd * g[3]; orow[64 * j] = r; }
    }
}

struct Args { const float* x; const float* ng; const float* w_in; const float* conv_w; const float* w_out; const float* rel_bias; const float* fg; float* out; unsigned char* ws; int ph_lo, ph_hi; };
__global__ void __launch_bounds__(NWAVES * 64, 2) mk_fwd(Args args) {
    extern __shared__ __attribute__((aligned(16))) unsigned char lds[];
    Frame F;
    F.lds = (LAS unsigned char*)lds;
    F.MISC = (volatile LAS unsigned*)(F.lds + MISC_OFF);
    F.wave = __builtin_amdgcn_readfirstlane((int)(threadIdx.x >> 6));
    F.G = gridDim.x; { const int bx = blockIdx.x; F.vcu = (F.G % 8 == 0) ? (bx % 8) * (F.G / 8) + bx / 8 : bx; }
    unsigned char* ws = args.ws;
    F.ctl = (unsigned*)(ws + WS_CTL);
    F.x = args.x; F.ng = args.ng; F.w_in = args.w_in; F.conv_w = args.conv_w; F.w_out = args.w_out; F.rel_bias = args.rel_bias; F.fg = args.fg; F.out = args.out;
    F.WinT = (bf16_t*)(ws + WS_WIN); F.WoutT = (bf16_t*)(ws + WS_WOUT); F.U = (bf16_t*)(ws + WS_U); F.PROJ = (bf16_t*)(ws + WS_PROJ); F.MIX = (bf16_t*)(ws + WS_MIX); F.PART = (bf16_t*)(ws + WS_PART);
    F.W8 = ws + WS_W8; F.U8 = ws + WS_U8;
    F.LSE = (float*)(ws + WS_LSE); F.KSUM = (float*)(ws + WS_KSUM); F.ROWSS = (float*)(ws + WS_ROWSS); F.LIST = (unsigned short*)(ws + WS_LIST); F.CNT = (int*)(ws + WS_CNT);
    for (int u = threadIdx.x; u < (LDS_BYTES - LDSCTL_OFF) / 4; u += NWAVES * 64) ((LAS unsigned*)(F.lds + LDSCTL_OFF))[u] = 0u;
    __syncthreads();
    XcdBarrier bar; bar.bar = F.ctl + CW_BAR; bar.x = 0; bar.st = nullptr;
    if (N_LAUNCHES == 1) bar = xcd_barrier_post(F.ctl + CW_BAR, F.MISC + 8);
#define GRID_BAR() do { if (N_LAUNCHES == 1) xcd_barrier(bar); } while (0)
    const int lo = args.ph_lo, hi = args.ph_hi;
#define IN(k) (lo <= (k) && (k) < hi)
#define BOTH(k) (IN(k) && IN((k) + 1))
    if (IN(0)) { p0_prologue(F); if (MK_DOUBLE == 0) { GRID_BAR(); p0_prologue(F); } if (BOTH(0)) GRID_BAR(); }
    if (IN(1)) {
        {
            pg8::Gemm g{F.U, F.WinT, SEQ, PW - 4096, DM}; pg8::StaticOrder S; S.init(SEQ, PW - 4096, F.G, (int)blockIdx.x, 16, 16);
            pg8::EpiProj E{F.PROJ, PW, F.KSUM};
            pg8::gemm_phase<pg8::EpiProj, pg8::StaticOrder, true, true, false>(F.lds, g, S, E, F.wave);
        }
        {
            pg8::Gemm g{F.U8, F.W8, SEQ, 4096, DM}; pg8::StaticOrder S; S.init(SEQ, 4096, F.G, (int)blockIdx.x);
            pg8::EpiProj E{F.PROJ + COL_V, PW, nullptr};
            pg8::gemm_phase<pg8::EpiProj, pg8::StaticOrder, true, true, true>(F.lds, g, S, E, F.wave);
        }
        if (BOTH(1)) GRID_BAR();
    }
    if (IN(2)) { p2_route(F); if (MK_DOUBLE == 2) { GRID_BAR(); p2_route(F); } if (BOTH(2)) GRID_BAR(); }
    if (IN(3)) { p3_attention(F, CW_ITEM); if (MK_DOUBLE == 3) { GRID_BAR(); p3_attention(F, CW_ITEM + 64); } if (BOTH(3)) GRID_BAR(); }
    if (IN(4)) { p4_mix(F); if (MK_DOUBLE == 4) { GRID_BAR(); p4_mix(F); } if (BOTH(4)) GRID_BAR(); }
    if (IN(5)) {
        pg8::Gemm g{F.MIX, F.WoutT, SEQ, DM, DM}; pg8::StaticOrder S; S.init(SEQ, DM, F.G, (int)blockIdx.x);
        pg8::EpiOut E{F.x, F.out, F.ROWSS};
        pg8::gemm_phase<pg8::EpiOut, pg8::StaticOrder, true, true>(F.lds, g, S, E, F.wave);
        if (MK_DOUBLE == 5) { GRID_BAR(); pg8::gemm_phase<pg8::EpiOut, pg8::StaticOrder, true, true>(F.lds, g, S, E, F.wave); }
        if (BOTH(5)) GRID_BAR();
    }
    if (IN(6)) { p6_final(F); }
#undef IN
#undef BOTH
}

extern "C" void kernel_launch(void* const* d_in, const int* in_sizes, int n_in, void* d_out, int out_size, void* d_ws, size_t ws_size, hipStream_t stream) {
    static int grid = 0;
    if (grid == 0) {
        if (n_in != 7 || in_sizes[0] != SEQ * DM || out_size != SEQ * DM || ws_size < WS_END) {
            fprintf(stderr, "kernel_launch: unexpected shapes (n_in %d, in0 %d, out %d, ws %zu); nothing launched\n", n_in, n_in > 0 ? in_sizes[0] : -1, out_size, ws_size); grid = -1; return; }
        int dev = 0, cus = 0, per_cu = 0;
        if (hipGetDevice(&dev) != hipSuccess || hipDeviceGetAttribute(&cus, hipDeviceAttributeMultiprocessorCount, dev) != hipSuccess) { fprintf(stderr, "kernel_launch: device query failed\n"); grid = -1; return; }
        if (hipFuncSetAttribute((const void*)mk_fwd, hipFuncAttributeMaxDynamicSharedMemorySize, LDS_BYTES) != hipSuccess) { fprintf(stderr, "kernel_launch: hipFuncSetAttribute failed\n"); grid = -1; return; }
        if (hipOccupancyMaxActiveBlocksPerMultiprocessor(&per_cu, (const void*)mk_fwd, NWAVES * 64, LDS_BYTES) != hipSuccess || per_cu < 1) {
            fprintf(stderr, "kernel_launch: occupancy query reports %d workgroups per CU\n", per_cu); (void)hipGetLastError(); grid = -1; return; }
        grid = cus;
    }
    if (grid < 0) return;
    (void)hipMemsetAsync((char*)d_ws + WS_CTL, 0, CTL_ZERO_BYTES, stream);
    Args a{};
    a.x = (const float*)d_in[0]; a.ng = (const float*)d_in[1]; a.w_in = (const float*)d_in[2]; a.conv_w = (const float*)d_in[3]; a.w_out = (const float*)d_in[4];
    a.rel_bias = (const float*)d_in[5]; a.fg = (const float*)d_in[6]; a.out = (float*)d_out; a.ws = (unsigned char*)d_ws;
    if (N_LAUNCHES == 1) { a.ph_lo = 0; a.ph_hi = N_PHASES; hipLaunchKernelGGL(mk_fwd, dim3(grid), dim3(NWAVES * 64), LDS_BYTES, stream, a); }
    else { for (int p = 0; p < N_PHASES; ++p) { a.ph_lo = p; a.ph_hi = p + 1; hipLaunchKernelGGL(mk_fwd, dim3(grid), dim3(NWAVES * 64), LDS_BYTES, stream, a); } }
}
```

```cpp
#include <hip/hip_runtime.h>
#include <cstdio>
#include <cstdint>
#include <cmath>

#ifndef MK_DOUBLE
#define MK_DOUBLE -1
#endif
#ifndef MK_N_LAUNCHES
#define MK_N_LAUNCHES 1
#endif

#define LAS __attribute__((address_space(3)))
#define GAS __attribute__((address_space(1)))
typedef unsigned short bf16_t;
typedef short bf16x8 __attribute__((ext_vector_type(8)));
typedef short s16x4 __attribute__((ext_vector_type(4)));
typedef float f32x4 __attribute__((ext_vector_type(4)));
typedef float f32x16 __attribute__((ext_vector_type(16)));
typedef unsigned u32x4 __attribute__((ext_vector_type(4)));
typedef unsigned u32x2 __attribute__((ext_vector_type(2)));
typedef float f32x2_t __attribute__((ext_vector_type(2)));
typedef __bf16 bf16x2_t __attribute__((ext_vector_type(2)));

constexpr int SEQ = 8192, DM = 4096, PW = 16384, AW = 2048, NH = 16, HD = 128, BLK = 256, NB = 32;
constexpr int COL_Q = 0, COL_K = 2048, COL_V = 4096, COL_ZA = 6144, COL_HC = 8192, COL_BG = 10240, COL_CG = 12288, COL_ZC = 14336;
constexpr float EPS = 1e-6f;
constexpr float LOG2E = 1.4426950408889634f;
constexpr float QK_C = 0.08838834764831845f * LOG2E;

__device__ __forceinline__ unsigned cvtpk(float lo, float hi) { f32x2_t v = {lo, hi}; bf16x2_t b = __builtin_convertvector(v, bf16x2_t); return __builtin_bit_cast(unsigned, b); }
__device__ __forceinline__ float bf_lo(unsigned w) { return __uint_as_float(w << 16); }
__device__ __forceinline__ float bf_hi(unsigned w) { return __uint_as_float(w & 0xffff0000u); }
__device__ __forceinline__ float silu_f(float z) { return z / (1.f + __expf(-z)); }
__device__ __forceinline__ int hw_lane() { int l; asm volatile("v_mbcnt_lo_u32_b32 %0, -1, 0\n\tv_mbcnt_hi_u32_b32 %0, -1, %0" : "=v"(l)); return l; }
__device__ __forceinline__ int crow(int r, int hi) { return (r & 3) + 8 * (r >> 2) + 4 * hi; }

namespace pg8 {
#define PG8_LAS __attribute__((address_space(3)))
__device__ __forceinline__ void glds16s(const void* sbase, unsigned voff, unsigned lds_dst) {
    unsigned keep;
    asm volatile("s_mov_b32 %0, m0\n\ts_mov_b32 m0, %3\n\ts_nop 0\n\tglobal_load_lds_dwordx4 %1, %2\n\ts_mov_b32 m0, %0" : "=&s"(keep) : "v"(voff), "s"(sbase), "s"(lds_dst) : "memory");
}
constexpr int BM = 256, BK = 64, HALF = 128, HTB = HALF * BK * 2, STAGE_BYTES = 8 * HTB, NXCD = 8, WGM = 8;
__host__ __device__ __forceinline__ int lds_byte(int r, int c) { const int st = (r >> 4) * 2 + (c >> 5), rr = r & 15, cc = c & 31, ob = rr * 64 + cc * 2; return st * 1024 + (ob ^ (((ob >> 9) & 1) << 5)); }
__host__ __device__ __forceinline__ void stage_rc(int b, int& R, int& C) { const int st = b / 1024, sb = b % 1024, swz = sb ^ (((sb >> 9) & 1) << 5); R = (st >> 1) * 16 + swz / 64; C = (st & 1) * 32 + (swz % 64) / 2; }
__host__ __device__ __forceinline__ int perm32(int rho) { const int n = rho >> 4, i = rho & 15; return 8 * (i >> 2) + 4 * n + (i & 3); }

struct Unit { int pm, pn; };
struct Gemm { const void* A; const void* Bt; int M, N, K; };

struct StaticOrder {
    int nM, nN, nwg, G, c, skip_from, skip_by;
    __host__ __device__ void init(int M, int N, int G_, int c_, int sf = 1 << 30, int sb = 0) { nM = M / BM; nN = N / BM; nwg = nM * nN; G = G_; c = c_; skip_from = sf; skip_by = sb; }
    __host__ __device__ bool next(int i, Unit& u) const {
        const long L = (long)i * G + c; if (L >= nwg) return false;
        int wgid = (int)L; { const int q = nwg / NXCD, r = nwg % NXCD, xcd = wgid % NXCD, off = wgid / NXCD; wgid = (xcd < r ? xcd * (q + 1) : r * (q + 1) + (xcd - r) * q) + off; }
        const int nig = WGM * nN, gid = wgid / nig, fm = gid * WGM, gsz = (nM - fm) < WGM ? (nM - fm) : WGM;
        u.pm = fm + ((wgid % nig) % gsz); u.pn = (wgid % nig) / gsz; if (u.pn >= skip_from) u.pn += skip_by; return true;
    }
    __device__ __forceinline__ void a_ready(const Unit&) const {}
    __device__ __forceinline__ void done(const Unit&) const {}
};

struct EpiProj {
    static constexpr bool PERM = true, AFTER_DRAIN = false;
    bf16_t* O; int ldc; float* ksum;
    __device__ __forceinline__ void operator()(const f32x4 (&acc)[2][2][4][2], const Unit& u, int wr, int wc, int fr, int fq) const {
        const int row0 = u.pm * BM + wr * 64 + fr; const int col0 = u.pn * BM + wc * 32 + 8 * fq;
#pragma unroll
        for (int ai = 0; ai < 2; ++ai)
#pragma unroll
            for (int m = 0; m < 4; ++m) { bf16_t* rowp = O + (size_t)(row0 + ai * HALF + m * 16) * ldc + col0;
#pragma unroll
                for (int bj = 0; bj < 2; ++bj) { const f32x4 v0 = acc[ai][bj][m][0], v1 = acc[ai][bj][m][1];
                    u32x4 w; w.x = cvtpk(v0[0], v0[1]); w.y = cvtpk(v0[2], v0[3]); w.z = cvtpk(v1[0], v1[1]); w.w = cvtpk(v1[2], v1[3]);
                    *(u32x4*)(rowp + bj * HALF) = w; } }
        if (ksum && u.pn >= 8 && u.pn < 16) {
            float* kp = ksum + (size_t)u.pm * 2048 + (u.pn - 8) * BM + wc * 32 + 8 * fq;
#pragma unroll
            for (int bj = 0; bj < 2; ++bj)
#pragma unroll
                for (int n = 0; n < 2; ++n) {
                    f32x4 s = acc[0][bj][0][n];
#pragma unroll
                    for (int m = 1; m < 4; ++m) s += acc[0][bj][m][n];
#pragma unroll
                    for (int m = 0; m < 4; ++m) s += acc[1][bj][m][n];
#pragma unroll
                    for (int j = 0; j < 4; ++j) { float v = s[j]; v += __shfl_xor(v, 1); v += __shfl_xor(v, 2); v += __shfl_xor(v, 4); v += __shfl_xor(v, 8);
                        if (fr == 0) atomicAdd(kp + bj * HALF + 4 * n + j, v); }
                }
        }
    }
};
struct EpiOut {
    static constexpr bool PERM = false, AFTER_DRAIN = false;
    const float* X; float* out; float* rowss;
    __device__ __forceinline__ void operator()(const f32x4 (&acc)[2][2][4][2], const Unit& u, int wr, int wc, int fr, int fq) const {
        const int col0 = u.pn * BM + wc * 32 + 4 * fq;
#pragma unroll
        for (int ai = 0; ai < 2; ++ai)
#pragma unroll
            for (int m = 0; m < 4; ++m) { const int row = u.pm * BM + ai * HALF + wr * 64 + m * 16 + fr; const size_t off = (size_t)row * DM + col0; float ss = 0.f;
#pragma unroll
                for (int bj = 0; bj < 2; ++bj)
#pragma unroll
                    for (int n = 0; n < 2; ++n) { const f32x4 xv = *(const f32x4*)(X + off + bj * HALF + n * 16); const f32x4 hv = xv + acc[ai][bj][m][n];
                        *(f32x4*)(out + off + bj * HALF + n * 16) = hv; ss += (hv[0] * hv[0] + hv[1] * hv[1]) + (hv[2] * hv[2] + hv[3] * hv[3]); }
                ss += __shfl_xor(ss, 16); ss += __shfl_xor(ss, 32);
                if (fq == 0) rowss[(size_t)row * 64 + u.pn * 4 + wc] = ss; }
    }
};

constexpr int F8_SCALE_W = 0x78787878, F8_SCALE_U = 0x7D7D7D7D;
typedef int v4i_t __attribute__((ext_vector_type(4)));
typedef int v8i_t __attribute__((ext_vector_type(8)));
template <class Epi, class Sched, bool ALIGN_EPI = false, bool SP2 = false, bool F8 = false>
__device__ __forceinline__ void gemm_phase(PG8_LAS unsigned char* lds, const Gemm g, const Sched& S, const Epi& E, int wid) {
    const int lane = hw_lane(), tid = wid * 64 + lane, wr = wid >> 2, wc = wid & 3, fr = lane & 15, fq = lane >> 4;
    const int pitch = g.K * (F8 ? 1 : 2), nt = pitch / 128;
    unsigned voffA[2], voffB[2];
#pragma unroll
    for (int i = 0; i < 2; ++i) { int R, C; stage_rc(tid * 16 + i * 8192, R, C); const int Rb = Epi::PERM ? ((R & ~31) + perm32(R & 31)) : R;
        voffA[i] = (unsigned)(R * pitch + C * 2); voffB[i] = (unsigned)(Rb * pitch + C * 2); }
    const size_t kstep = (size_t)(BK * 2);
    const size_t hstep = (size_t)HALF * pitch;
    const size_t tstep = 2 * hstep;
    const unsigned ldsb = (unsigned)__builtin_amdgcn_readfirstlane((int)((unsigned)(uintptr_t)lds + (unsigned)wid * 1024u));
    const int aoff = lds_byte(wr * 64 + fr, fq * 8), boff = lds_byte(wc * 32 + fr, fq * 8);
#define PG8_SA(b, h) (((b) * 2 + (h)) * HTB)
#define PG8_SB(b, h) ((4 + (b) * 2 + (h)) * HTB)
#define PG8_STAGE(bufoff, gbase, voff) do { _Pragma("unroll") for (int _i = 0; _i < 2; ++_i) \
        glds16s((const void*)(gbase), (voff)[_i], ldsb + (unsigned)((bufoff) + _i * 8192)); } while (0)
#define PG8_LDA(dst, b, h) do { _Pragma("unroll") for (int m = 0; m < 4; ++m) _Pragma("unroll") for (int k = 0; k < 2; ++k) dst[m][k] = *(const PG8_LAS bf16x8*)(lds + PG8_SA(b, h) + aoff + m * 2048 + k * 1024); } while (0)
#define PG8_LDB(dst, b, h) do { _Pragma("unroll") for (int n = 0; n < 2; ++n) _Pragma("unroll") for (int k = 0; k < 2; ++k) dst[n][k] = *(const PG8_LAS bf16x8*)(lds + PG8_SB(b, h) + boff + n * 2048 + k * 1024); } while (0)
#define PG8_MMA(ai, bj, At, Bt) do { __builtin_amdgcn_s_setprio(1); _Pragma("unroll") for (int m = 0; m < 4; ++m) _Pragma("unroll") for (int n = 0; n < 2; ++n) _Pragma("unroll") for (int k = 0; k < 2; ++k) \
        acc[ai][bj][m][n] = __builtin_amdgcn_mfma_f32_16x16x32_bf16(Bt[n][k], At[m][k], acc[ai][bj][m][n], 0, 0, 0); __builtin_amdgcn_s_setprio(0); } while (0)
#define PG8_CAT(x0, x1) __builtin_shufflevector(__builtin_bit_cast(v4i_t, x0), __builtin_bit_cast(v4i_t, x1), 0, 1, 2, 3, 4, 5, 6, 7)
#define PG8_MMA8(ai, bj, At, Bt) do { __builtin_amdgcn_s_setprio(1); _Pragma("unroll") for (int m = 0; m < 4; ++m) _Pragma("unroll") for (int n = 0; n < 2; ++n) \
        acc[ai][bj][m][n] = __builtin_amdgcn_mfma_scale_f32_16x16x128_f8f6f4(PG8_CAT(Bt[n][0], Bt[n][1]), PG8_CAT(At[m][0], At[m][1]), acc[ai][bj][m][n], 0, 0, 0, F8_SCALE_W, 0, F8_SCALE_U); __builtin_amdgcn_s_setprio(0); } while (0)
#define PG8_MM(ai, bj, At, Bt) do { if constexpr (F8) PG8_MMA8(ai, bj, At, Bt); else PG8_MMA(ai, bj, At, Bt); } while (0)
#define PG8_WAIT_V(n) asm volatile("s_waitcnt vmcnt(" #n ")" ::: "memory")
#define PG8_WAIT_L(n) asm volatile("s_waitcnt lgkmcnt(" #n ")" ::: "memory")
#define PG8_BAR __builtin_amdgcn_s_barrier()
#define PG8_SCHED __builtin_amdgcn_sched_barrier(0)
    Unit cur, nxt; int ui = 0;
    if (!S.next(0, cur)) return;
    f32x4 acc[2][2][4][2];
#pragma unroll
    for (int a = 0; a < 2; ++a)
#pragma unroll
        for (int b = 0; b < 2; ++b)
#pragma unroll
            for (int m = 0; m < 4; ++m)
#pragma unroll
                for (int n = 0; n < 2; ++n) acc[a][b][m][n] = (f32x4){0.f, 0.f, 0.f, 0.f};
    bf16x8 At[4][2], B0[2][2], B1[2][2];
    const char* cA = (const char*)g.A + (size_t)cur.pm * tstep; const char* cB = (const char*)g.Bt + (size_t)cur.pn * tstep;
    S.a_ready(cur);
    if constexpr (SP2) {
        PG8_STAGE(PG8_SB(0, 0), cB, voffB); PG8_STAGE(PG8_SB(0, 1), cB + hstep, voffB); PG8_STAGE(PG8_SA(0, 0), cA, voffA); PG8_STAGE(PG8_SA(0, 1), cA + hstep, voffA);
        if (wr == 1) PG8_BAR;
        PG8_WAIT_V(2); PG8_BAR;
        PG8_STAGE(PG8_SB(1, 0), cB + kstep, voffB); PG8_STAGE(PG8_SA(1, 0), cA + kstep, voffA); PG8_STAGE(PG8_SB(1, 1), cB + hstep + kstep, voffB);
        PG8_WAIT_V(6); PG8_BAR;
    } else {
        PG8_STAGE(PG8_SB(0, 0), cB, voffB); PG8_STAGE(PG8_SA(0, 0), cA, voffA); PG8_STAGE(PG8_SB(0, 1), cB + hstep, voffB); PG8_STAGE(PG8_SA(0, 1), cA + hstep, voffA);
        if (wr == 1) PG8_BAR;
        PG8_WAIT_V(4); PG8_BAR;
        PG8_STAGE(PG8_SB(1, 0), cB + kstep, voffB); PG8_STAGE(PG8_SA(1, 0), cA + kstep, voffA); PG8_STAGE(PG8_SB(1, 1), cB + hstep + kstep, voffB);
        PG8_WAIT_V(6); PG8_BAR;
    }
    for (;;) {
        const bool has_next = S.next(ui + 1, nxt);
        const char* nA = has_next ? (const char*)g.A + (size_t)nxt.pm * tstep : cA; const char* nB = has_next ? (const char*)g.Bt + (size_t)nxt.pn * tstep : cB;
        for (int t = 0; t < nt; t += 2) {
            const bool last = (t == nt - 2);
            const char* a1 = cA + (size_t)(t + 1) * kstep;
            const char* a2 = last ? nA : cA + (size_t)(t + 2) * kstep; const char* b2 = last ? nB : cB + (size_t)(t + 2) * kstep;
            const char* a3 = a2 + kstep; const char* b3 = b2 + kstep;
            if (last && has_next) S.a_ready(nxt);
            if constexpr (SP2) {
            PG8_LDB(B0, 0, 0); PG8_LDB(B1, 0, 1); PG8_SCHED; PG8_LDA(At, 0, 0); PG8_STAGE(PG8_SA(1, 1), a1 + hstep, voffA);
            PG8_WAIT_V(8); PG8_WAIT_L(0); PG8_BAR; PG8_MM(0, 0, At, B0); PG8_MM(0, 1, At, B1); PG8_BAR; PG8_SCHED;
            PG8_LDA(At, 0, 1); PG8_STAGE(PG8_SB(0, 0), b2, voffB); PG8_STAGE(PG8_SB(0, 1), b2 + hstep, voffB); PG8_STAGE(PG8_SA(0, 0), a2, voffA);
            PG8_WAIT_V(8); PG8_WAIT_L(0); PG8_BAR; PG8_MM(1, 0, At, B0); PG8_MM(1, 1, At, B1); PG8_BAR; PG8_SCHED;
            PG8_LDB(B0, 1, 0); PG8_LDB(B1, 1, 1); PG8_SCHED; PG8_LDA(At, 1, 0); PG8_STAGE(PG8_SA(0, 1), a2 + hstep, voffA);
            PG8_WAIT_V(8); PG8_WAIT_L(0); PG8_BAR; PG8_MM(0, 0, At, B0); PG8_MM(0, 1, At, B1); PG8_BAR; PG8_SCHED;
            PG8_LDA(At, 1, 1); PG8_STAGE(PG8_SB(1, 0), b3, voffB); PG8_STAGE(PG8_SB(1, 1), b3 + hstep, voffB); PG8_STAGE(PG8_SA(1, 0), a3, voffA);
            PG8_WAIT_V(8); PG8_WAIT_L(0); PG8_BAR; PG8_MM(1, 0, At, B0); PG8_MM(1, 1, At, B1); PG8_BAR; PG8_SCHED;
            } else {
            PG8_LDB(B0, 0, 0); PG8_SCHED; PG8_LDA(At, 0, 0); PG8_STAGE(PG8_SA(1, 1), a1 + hstep, voffA);
            PG8_WAIT_L(8); PG8_BAR; PG8_WAIT_L(0); PG8_MM(0, 0, At, B0); PG8_BAR; PG8_SCHED;
            PG8_LDB(B1, 0, 1); PG8_STAGE(PG8_SB(0, 0), b2, voffB);
            PG8_BAR; PG8_WAIT_L(0); PG8_MM(0, 1, At, B1); PG8_BAR;
            PG8_LDA(At, 0, 1); PG8_STAGE(PG8_SA(0, 0), a2, voffA);
            PG8_BAR; PG8_WAIT_L(0); PG8_MM(1, 0, At, B0); PG8_BAR; PG8_SCHED;
            PG8_STAGE(PG8_SB(0, 1), b2 + hstep, voffB);
            PG8_WAIT_V(6); PG8_BAR; PG8_MM(1, 1, At, B1); PG8_BAR;
            PG8_LDB(B0, 1, 0); PG8_SCHED; PG8_LDA(At, 1, 0); PG8_STAGE(PG8_SA(0, 1), a2 + hstep, voffA);
            PG8_WAIT_L(8); PG8_BAR; PG8_WAIT_L(0); PG8_MM(0, 0, At, B0); PG8_BAR; PG8_SCHED;
            PG8_LDB(B1, 1, 1); PG8_STAGE(PG8_SB(1, 0), b3, voffB);
            PG8_BAR; PG8_WAIT_L(0); PG8_MM(0, 1, At, B1); PG8_BAR;
            PG8_LDA(At, 1, 1); PG8_STAGE(PG8_SA(1, 0), a3, voffA);
            PG8_BAR; PG8_WAIT_L(0); PG8_MM(1, 0, At, B0); PG8_BAR; PG8_SCHED;
            PG8_STAGE(PG8_SB(1, 1), b3 + hstep, voffB);
            PG8_WAIT_V(6); PG8_BAR; PG8_MM(1, 1, At, B1); PG8_BAR;
            }
        }
        if constexpr (ALIGN_EPI) { if (wr == 0) PG8_BAR; }
        if constexpr (!Epi::AFTER_DRAIN) { E(acc, cur, wr, wc, fr, fq); S.done(cur); }
        if (!has_next) break;
#pragma unroll
        for (int a = 0; a < 2; ++a)
#pragma unroll
            for (int b = 0; b < 2; ++b)
#pragma unroll
                for (int m = 0; m < 4; ++m)
#pragma unroll
                    for (int n = 0; n < 2; ++n) acc[a][b][m][n] = (f32x4){0.f, 0.f, 0.f, 0.f};
        cur = nxt; cA = nA; cB = nB; ++ui;
        if constexpr (ALIGN_EPI) { if (wr == 1) PG8_BAR; }
    }
    PG8_WAIT_V(0);
    if constexpr (!ALIGN_EPI) { if (wr == 0) PG8_BAR; }
    PG8_BAR;
#undef PG8_SA
#undef PG8_SB
#undef PG8_STAGE
#undef PG8_LDA
#undef PG8_LDB
#undef PG8_MMA
#undef PG8_MMA8
#undef PG8_MM
#undef PG8_CAT
#undef PG8_WAIT_V
#undef PG8_WAIT_L
#undef PG8_BAR
#undef PG8_SCHED
}
}

constexpr int NWAVES = 8;
constexpr int N_LAUNCHES = MK_N_LAUNCHES;
constexpr int N_PHASES = 7;

constexpr size_t MiB = 1u << 20;
constexpr size_t WS_CTL = 0, CTL_ZERO_BYTES = 1 * MiB;
constexpr size_t WS_WIN = 2 * MiB;
constexpr size_t WS_WOUT = 130 * MiB;
constexpr size_t WS_U = 162 * MiB;
constexpr size_t WS_PROJ = 226 * MiB;
constexpr size_t WS_MIX = 482 * MiB;
constexpr size_t WS_PART = 546 * MiB;
constexpr size_t WS_LSE = 674 * MiB;
constexpr size_t WS_KSUM = 676 * MiB;
constexpr size_t WS_LIST = 677 * MiB;
constexpr size_t WS_CNT = 685 * MiB;
constexpr size_t WS_ROWSS = 686 * MiB;
constexpr size_t WS_W8 = 688 * MiB;
constexpr size_t WS_U8 = 720 * MiB;
constexpr size_t WS_END = 752 * MiB;
constexpr int CW_BAR = 4096;
constexpr int CW_ITEM = 64;

constexpr int RING_BYTES = 131072;
constexpr int LDSCTL_OFF = RING_BYTES, MISC_OFF = LDSCTL_OFF + 320;
constexpr int ATT_LUT_OFF = RING_BYTES + 1024;
constexpr int ATT_MISC_OFF = ATT_LUT_OFF + 3072;
constexpr int LDS_BYTES = 147456;

typedef GAS unsigned gu32;
#define RLX_AGENT __ATOMIC_RELAXED, __HIP_MEMORY_SCOPE_AGENT
#define LDS_WAIT() asm volatile("s_waitcnt lgkmcnt(0)" ::: "memory")
#define VM_WAIT() asm volatile("s_waitcnt vmcnt(0)" ::: "memory")

#define XB_TMO      128
#define XB_XCNT(j)  (256  + 64 * (j))
#define XB_XSUB(j)  (1280 + 64 * (j))
#define XB_XGEN(j)  (2304 + 64 * (j))
#define XB_TOP      3328
#define XB_TOPGEN   3392
#define XCD_BAR_WORDS 3456
#define XB_SPIN_CAP (1u << 20)
__device__ __forceinline__ unsigned xb_ld(unsigned* p)              { return __hip_atomic_load(p, __ATOMIC_RELAXED, __HIP_MEMORY_SCOPE_AGENT); }
__device__ __forceinline__ unsigned xb_add(unsigned* p, unsigned v) { return __hip_atomic_fetch_add(p, v, __ATOMIC_RELAXED, __HIP_MEMORY_SCOPE_AGENT); }
__device__ __forceinline__ unsigned xb_xcc_id() { return (unsigned)__builtin_amdgcn_s_getreg((3 << 11) | 20) & 0xFu; }
#define XB_SPIN(cond, bar) do { unsigned _sp = 0; while (cond) { __builtin_amdgcn_s_sleep(1); \
    if ((++_sp & 255u) == 0u) { if (xb_ld(&(bar)[XB_TMO])) break; if (_sp > XB_SPIN_CAP) { atomicAdd(&(bar)[XB_TMO], 1u); break; } } } } while (0)
struct XcdBarrier { unsigned* bar; unsigned x; volatile LAS unsigned* st; };
__device__ __forceinline__ XcdBarrier xcd_barrier_post(unsigned* bar, volatile LAS unsigned* st) {
    XcdBarrier b; b.bar = bar; b.x = xb_xcc_id(); b.st = st;
    if (threadIdx.x == 0) (void)xb_add(&bar[XB_XCNT(b.x)], 1u);
    return b;
}
__device__ __forceinline__ void xcd_barrier_complete(unsigned* bar, unsigned x, unsigned& nloc, unsigned& nx) {
    const unsigned G = gridDim.x * gridDim.y * gridDim.z;
    unsigned sum, cnt, mine, sp = 0u;
    for (;;) {
        sum = 0u; cnt = 0u; mine = 0u;
#pragma unroll
        for (unsigned j = 0; j < 16; ++j) { const unsigned c = xb_ld(&bar[XB_XCNT(j)]); sum += c; cnt += (c > 0u) ? 1u : 0u; mine = (j == x) ? c : mine; }
        if (sum == G) break;
        __builtin_amdgcn_s_sleep(1);
        if ((++sp & 255u) == 0u) { if (xb_ld(&bar[XB_TMO])) break; if (sp > XB_SPIN_CAP) { atomicAdd(&bar[XB_TMO], 1u); break; } }
    }
    nloc = mine > 0u ? mine : 1u; nx = cnt > 0u ? cnt : 1u;
}
__device__ __forceinline__ void xcd_barrier(const XcdBarrier& b) {
    asm volatile("s_waitcnt vmcnt(0)" ::: "memory");
    __syncthreads();
    if (threadIdx.x == 0) {
        unsigned* bar = b.bar;
        __builtin_amdgcn_s_waitcnt(0);
        unsigned nloc = b.st[0], nx = b.st[1];
        if (nloc == 0u) { xcd_barrier_complete(bar, b.x, nloc, nx); b.st[0] = nloc; b.st[1] = nx; }
        const unsigned old = xb_add(&bar[XB_XSUB(b.x)], 1u);
        const unsigned gen = old / nloc;
        if (old + 1u == (gen + 1u) * nloc) {
            __builtin_amdgcn_fence(__ATOMIC_RELEASE, "agent");
            asm volatile("s_waitcnt vmcnt(0)" ::: "memory");
            const unsigned og = xb_add(&bar[XB_TOP], 1u);
            const unsigned tg = og / nx;
            if (og + 1u == (tg + 1u) * nx) xb_add(&bar[XB_TOPGEN], 1u);
            else XB_SPIN(xb_ld(&bar[XB_TOPGEN]) == tg, bar);
            __builtin_amdgcn_fence(__ATOMIC_ACQUIRE, "agent");
            xb_add(&bar[XB_XGEN(b.x)], 1u);
            asm volatile("s_waitcnt vmcnt(0)" ::: "memory");
        } else {
            XB_SPIN(xb_ld(&bar[XB_XGEN(b.x)]) == gen, bar);
            __builtin_amdgcn_fence(__ATOMIC_ACQUIRE, "agent");
            asm volatile("s_waitcnt vmcnt(0)" ::: "memory");
        }
    }
    __syncthreads();
}

struct Frame {
    LAS unsigned char* lds;
    volatile LAS unsigned* MISC;
    unsigned* ctl;
    int wave, vcu, G;
    const float *x, *ng, *w_in, *conv_w, *w_out, *rel_bias, *fg; float* out;
    bf16_t *WinT, *WoutT, *U, *PROJ, *MIX, *PART; unsigned char *W8, *U8; float *LSE, *KSUM, *ROWSS; unsigned short* LIST; int* CNT;
};

__device__ __forceinline__ float wave_sum(float v) {
#pragma unroll
    for (int o = 1; o < 64; o <<= 1) v += __shfl_xor(v, o);
    return v;
}

__device__ __forceinline__ void p0_tile_load(f32x4 (&v)[8], const float* W, int N, int kb, int nb, int wave, int lane) {
    const float* src = W + (size_t)(64 * kb + 8 * wave) * N + 256 * nb + 4 * lane;
#pragma unroll
    for (int i = 0; i < 8; ++i) v[i] = *(const f32x4*)(src + (size_t)i * N);
}
__device__ __forceinline__ void p0_tile_store(const f32x4 (&v)[8], bf16_t* WT, int kb, int nb, LAS unsigned* T, int tid, int wave, int lane) {
#pragma unroll
    for (int ii = 0; ii < 4; ++ii) { const int kp = 4 * wave + ii; u32x4 d;
        d.x = cvtpk(v[2 * ii][0], v[2 * ii + 1][0]); d.y = cvtpk(v[2 * ii][1], v[2 * ii + 1][1]); d.z = cvtpk(v[2 * ii][2], v[2 * ii + 1][2]); d.w = cvtpk(v[2 * ii][3], v[2 * ii + 1][3]);
        *(LAS u32x4*)(T + kp * 256 + ((4 * lane) ^ (wave << 2))) = d; }
    LDS_WAIT(); __syncthreads();
#pragma unroll
    for (int i = 0; i < 4; ++i) { const int idx = tid + 512 * i, n = idx >> 3, c = idx & 7; u32x4 o;
        const LAS unsigned* tp = T + (4 * c) * 256 + (n ^ (c << 2));
        o.x = tp[0]; o.y = tp[256]; o.z = tp[512]; o.w = tp[768];
        *(u32x4*)(WT + (size_t)(256 * nb + n) * 4096 + 64 * kb + 8 * c) = o; }
    LDS_WAIT(); __syncthreads();
}
__device__ __forceinline__ void p0_tile_store_f8(const f32x4 (&v)[8], unsigned char* W8, int kb, int nb8, LAS unsigned* T, int tid, int wave, int lane) {
#pragma unroll
    for (int q2 = 0; q2 < 2; ++q2) { const int kq = 2 * wave + q2; u32x4 d;
#pragma unroll
        for (int c = 0; c < 4; ++c) { int w32 = __builtin_amdgcn_cvt_pk_fp8_f32(v[4 * q2][c] * 128.f, v[4 * q2 + 1][c] * 128.f, 0, false); w32 = __builtin_amdgcn_cvt_pk_fp8_f32(v[4 * q2 + 2][c] * 128.f, v[4 * q2 + 3][c] * 128.f, w32, true); d[c] = (unsigned)w32; }
        *(LAS u32x4*)(T + kq * 256 + ((4 * lane) ^ (((kq >> 2) & 3) << 3))) = d; }
    LDS_WAIT(); __syncthreads();
#pragma unroll
    for (int i = 0; i < 2; ++i) { const int idx = tid + 512 * i, n = idx >> 2, c = idx & 3; u32x4 o;
        const LAS unsigned* tp = T + (4 * c) * 256 + (n ^ (c << 3));
        o.x = tp[0]; o.y = tp[256]; o.z = tp[512]; o.w = tp[768];
        *(u32x4*)(W8 + (size_t)(256 * nb8 + n) * 4096 + 64 * kb + 16 * c) = o; }
    LDS_WAIT(); __syncthreads();
}
__device__ __forceinline__ void p0_decode(int it, const float* w_in, const float* w_out, bf16_t* WinT, bf16_t* WoutT, const float*& W, int& N, bf16_t*& WT, int& kb, int& nb) {
    if (it < 4096) { W = w_in; N = PW; WT = WinT; nb = it & 63; kb = it >> 6; }
    else { const int r = it - 4096; W = w_out; N = DM; WT = WoutT; nb = r & 15; kb = r >> 4; }
}
__device__ __forceinline__ void p0_tile_out(const f32x4 (&v)[8], Frame& F, bf16_t* WT, int kb, int nb, LAS unsigned* T, int tid, int lane) {
    if (WT == F.WinT && nb < 32) p0_tile_store_f8(v, F.W8, kb, nb, T, tid, F.wave, lane);
    else p0_tile_store(v, WT, kb, nb, T, tid, F.wave, lane);
}
__device__ __forceinline__ void p0_prologue(Frame& F) {
    const int lane = hw_lane(), tid = F.wave * 64 + lane;
    { const int gt = F.vcu * 512 + tid, NT = F.G * 512; for (int i = gt; i < NB * 2048 / 4; i += NT) ((f32x4*)F.KSUM)[i] = (f32x4){0.f, 0.f, 0.f, 0.f}; }
    {
        LAS unsigned* T = (LAS unsigned*)F.lds;
        constexpr int NIT = 4096 + 1024;
        f32x4 va[8], vb[8]; const float* W; int N, kb, nb; bf16_t* WT;
        int it = F.vcu;
        if (it < NIT) { p0_decode(it, F.w_in, F.w_out, F.WinT, F.WoutT, W, N, WT, kb, nb); p0_tile_load(va, W, N, kb, nb, F.wave, lane); }
        while (it < NIT) {
            const float* W2; int N2, kb2, nb2; bf16_t* WT2; const int it2 = it + F.G;
            if (it2 < NIT) { p0_decode(it2, F.w_in, F.w_out, F.WinT, F.WoutT, W2, N2, WT2, kb2, nb2); p0_tile_load(vb, W2, N2, kb2, nb2, F.wave, lane); }
            p0_tile_out(va, F, WT, kb, nb, T, tid, lane);
            it = it2; if (it >= NIT) break;
            const int it3 = it + F.G;
            if (it3 < NIT) { p0_decode(it3, F.w_in, F.w_out, F.WinT, F.WoutT, W, N, WT, kb, nb); p0_tile_load(va, W, N, kb, nb, F.wave, lane); }
            p0_tile_out(vb, F, WT2, kb2, nb2, T, tid, lane);
            it = it3;
        }
    }
    {
        const int gw = F.vcu * NWAVES + F.wave, NGW = F.G * NWAVES;
        for (int row = gw; row < SEQ; row += NGW) {
            const f32x4* xr = (const f32x4*)(F.x + (size_t)row * DM) + lane; f32x4 v[16]; float ss = 0.f;
#pragma unroll
            for (int j = 0; j < 16; ++j) { v[j] = xr[64 * j]; ss += (v[j][0] * v[j][0] + v[j][1] * v[j][1]) + (v[j][2] * v[j][2] + v[j][3] * v[j][3]); }
            const float rstd = 1.0f / sqrtf(wave_sum(ss) * (1.f / DM) + EPS);
            const f32x4* gr = (const f32x4*)F.ng + lane; u32x2* o8 = (u32x2*)(F.U + (size_t)row * DM) + lane; unsigned* o4 = (unsigned*)(F.U8 + (size_t)row * DM) + lane;
#pragma unroll
            for (int j = 0; j < 16; ++j) { const f32x4 g = gr[64 * j]; const float u0 = v[j][0] * rstd * g[0], u1 = v[j][1] * rstd * g[1], u2 = v[j][2] * rstd * g[2], u3 = v[j][3] * rstd * g[3];
                u32x2 w; w.x = cvtpk(u0, u1); w.y = cvtpk(u2, u3); o8[64 * j] = w;
                int w8 = __builtin_amdgcn_cvt_pk_fp8_f32(u0 * 4.f, u1 * 4.f, 0, false); w8 = __builtin_amdgcn_cvt_pk_fp8_f32(u2 * 4.f, u3 * 4.f, w8, true); o4[64 * j] = (unsigned)w8; }
        }
    }
}

#define TOP_BETTER(v, i, w, k) ((v) > (w) || ((v) == (w) && (i) < (k)))
#define TOP_INSERT(v, i) do { if (TOP_BETTER(v, i, v0, i0)) { v2 = v1; i2 = i1; v1 = v0; i1 = i0; v0 = (v); i0 = (i); } \
    else if (TOP_BETTER(v, i, v1, i1)) { v2 = v1; i2 = i1; v1 = (v); i1 = (i); } else if (TOP_BETTER(v, i, v2, i2)) { v2 = (v); i2 = (i); } } while (0)
__device__ __forceinline__ void p2_route(Frame& F) {
    const int lane = hw_lane(), tid = F.wave * 64 + lane;
    LAS int* lcnt = (LAS int*)F.lds;
    const int r32 = lane & 31, hi = lane >> 5;
    for (int u = F.vcu; u < NH * (NB - 1); u += F.G) {
        const int h = u & 15, qb = 1 + (u >> 4);
        if (tid < 32) lcnt[tid] = 0;
        __syncthreads();
        bf16x8 khi[8], klo[8], q[8];
        const float* kp = F.KSUM + (size_t)r32 * 2048 + h * HD + 8 * hi;
        const int ql = 32 * F.wave + r32, s = qb * BLK + ql;
        const bf16_t* qp = F.PROJ + (size_t)s * PW + COL_Q + h * HD + 8 * hi;
#pragma unroll
        for (int st = 0; st < 8; ++st) {
            const f32x4 a = *(const f32x4*)(kp + 16 * st), b = *(const f32x4*)(kp + 16 * st + 4);
            float f[8] = {a[0], a[1], a[2], a[3], b[0], b[1], b[2], b[3]}; u32x4 wh, wl; unsigned hh[4], ll[4];
#pragma unroll
            for (int e = 0; e < 4; ++e) { const float x0 = f[2 * e] * (1.f / 256.f), x1 = f[2 * e + 1] * (1.f / 256.f); const unsigned w = cvtpk(x0, x1); hh[e] = w; ll[e] = cvtpk(x0 - bf_lo(w), x1 - bf_hi(w)); }
            wh = (u32x4){hh[0], hh[1], hh[2], hh[3]}; wl = (u32x4){ll[0], ll[1], ll[2], ll[3]};
            khi[st] = __builtin_bit_cast(bf16x8, wh); klo[st] = __builtin_bit_cast(bf16x8, wl);
            q[st] = *(const bf16x8*)(qp + 16 * st);
        }
        f32x16 acc; for (int r = 0; r < 16; ++r) acc[r] = 0.f;
#pragma unroll
        for (int st = 0; st < 8; ++st) { acc = __builtin_amdgcn_mfma_f32_32x32x16_bf16(khi[st], q[st], acc, 0, 0, 0); acc = __builtin_amdgcn_mfma_f32_32x32x16_bf16(klo[st], q[st], acc, 0, 0, 0); }
        float v0 = -INFINITY, v1 = -INFINITY, v2 = -INFINITY; int i0 = 64, i1 = 65, i2 = 66;
#pragma unroll
        for (int r = 0; r < 16; ++r) { const int blk = crow(r, hi); const float v = (blk < qb) ? acc[r] : -INFINITY; TOP_INSERT(v, blk); }
        { const float p0 = __shfl_xor(v0, 32), p1 = __shfl_xor(v1, 32), p2 = __shfl_xor(v2, 32); const int j0 = __shfl_xor(i0, 32), j1 = __shfl_xor(i1, 32), j2 = __shfl_xor(i2, 32);
          TOP_INSERT(p0, j0); TOP_INSERT(p1, j1); TOP_INSERT(p2, j2); }
        const int nv = qb < 3 ? qb : 3;
        if (hi == 0) {
            const int sel[3] = {i0, i1, i2};
#pragma unroll
            for (int r = 0; r < 3; ++r) if (r < nv) { const int n = sel[r]; const int pos = __hip_atomic_fetch_add(lcnt + n, 1, __ATOMIC_RELAXED, __HIP_MEMORY_SCOPE_WORKGROUP);
                F.LIST[(((size_t)h * NB + n) * NB + qb) * BLK + pos] = (unsigned short)(ql | (r << 8)); }
        }
        LDS_WAIT(); __syncthreads();
        if (tid < qb) F.CNT[((size_t)h * NB + tid) * NB + qb] = lcnt[tid];
        __syncthreads();
    }
}

constexpr int N_ITEMS_PER_HEAD = 95;
__device__ __forceinline__ void item_decode(int e, int& j, int& lo, int& hq, int& own) {
    constexpr int ARB[8] = {1, 3, 5, 8, 12, 17, 24, 32};
    constexpr int CUM[8] = {0, 2, 6, 13, 24, 40, 63, 94};
    j = 31; lo = 32; hq = 32; own = 1;
#pragma unroll
    for (int ri = 0; ri < 7; ++ri) if (e >= CUM[ri] && e < CUM[ri + 1]) { j = e - CUM[ri]; lo = ARB[ri] > j + 1 ? ARB[ri] : j + 1; hq = ARB[ri + 1]; own = (ri == 0 || ARB[ri] <= j + 1) ? 1 : 0; }
}

template <bool GENERAL>
__device__ __forceinline__ void att_tile(const LAS unsigned char* Kl, const LAS unsigned char* Vl, const LAS float* lutp, float c31, int nkt,
                                         const bf16x8 (&qr)[8], int r32, int hi, int lane, float& m_out, float& l_out, f32x16 (&o)[4]) {
    float m = -1e30f, l = 0.f;
#pragma unroll
    for (int d0 = 0; d0 < 4; ++d0) for (int r = 0; r < 16; ++r) o[d0][r] = 0.f;
    const int X = (r32 & 15) << 4;
    const int i16 = lane & 15, qq = i16 >> 2, pp = i16 & 3, blk = (lane >> 4) & 1;
    int vb[4];
#pragma unroll
    for (int d0 = 0; d0 < 4; ++d0) vb[d0] = 256 * (4 * hi + qq) + 16 * (4 * (d0 ^ qq) + 2 * blk + (pp >> 1)) + 8 * (pp & 1);
    for (int kt = 0; kt < nkt; ++kt) {
        f32x16 p0, p1;
#pragma unroll
        for (int r = 0; r < 16; ++r) { p0[r] = 0.f; p1[r] = 0.f; }
        const LAS unsigned char* kr = Kl + 256 * (64 * kt + r32);
#pragma unroll
        for (int st = 0; st < 8; ++st) {
            const int cb = (32 * st + 16 * hi) ^ X;
            const bf16x8 a0 = *(const LAS bf16x8*)(kr + cb), a1 = *(const LAS bf16x8*)(kr + 32 * 256 + cb);
            p0 = __builtin_amdgcn_mfma_f32_32x32x16_bf16(a0, qr[st], p0, 0, 0, 0);
            p1 = __builtin_amdgcn_mfma_f32_32x32x16_bf16(a1, qr[st], p1, 0, 0, 0);
        }
        if (GENERAL) {
            const LAS float* lp = lutp - 64 * kt;
#pragma unroll
            for (int r = 0; r < 16; ++r) { const int kk = (r & 3) + 8 * (r >> 2); p0[r] = fmaf(p0[r], QK_C, lp[-kk]); p1[r] = fmaf(p1[r], QK_C, lp[-kk - 32]); }
        } else {
#pragma unroll
            for (int r = 0; r < 16; ++r) { p0[r] = fmaf(p0[r], QK_C, c31); p1[r] = fmaf(p1[r], QK_C, c31); }
        }
        float pmax = fmaxf(p0[0], p1[0]);
#pragma unroll
        for (int r = 1; r < 16; ++r) pmax = fmaxf(pmax, fmaxf(p0[r], p1[r]));
        { auto rr = __builtin_amdgcn_permlane32_swap(__float_as_uint(pmax), __float_as_uint(pmax), false, false); pmax = fmaxf(__uint_as_float(rr[0]), __uint_as_float(rr[1])); }
        const float mn = fmaxf(m, pmax);
        if (__any(mn > m)) {
            const float alpha = __builtin_amdgcn_exp2f(m - mn);
            l *= alpha;
#pragma unroll
            for (int d0 = 0; d0 < 4; ++d0) for (int r = 0; r < 16; ++r) o[d0][r] *= alpha;
            m = mn;
        }
        float ps = 0.f;
#pragma unroll
        for (int r = 0; r < 16; ++r) { p0[r] = __builtin_amdgcn_exp2f(p0[r] - m); p1[r] = __builtin_amdgcn_exp2f(p1[r] - m); ps += p0[r] + p1[r]; }
        l += ps;
        bf16x8 pb[4];
#pragma unroll
        for (int s2 = 0; s2 < 2; ++s2) {
            u32x4 w0 = {cvtpk(p0[8 * s2], p0[8 * s2 + 1]), cvtpk(p0[8 * s2 + 2], p0[8 * s2 + 3]), cvtpk(p0[8 * s2 + 4], p0[8 * s2 + 5]), cvtpk(p0[8 * s2 + 6], p0[8 * s2 + 7])};
            u32x4 w1 = {cvtpk(p1[8 * s2], p1[8 * s2 + 1]), cvtpk(p1[8 * s2 + 2], p1[8 * s2 + 3]), cvtpk(p1[8 * s2 + 4], p1[8 * s2 + 5]), cvtpk(p1[8 * s2 + 6], p1[8 * s2 + 7])};
            pb[s2] = __builtin_bit_cast(bf16x8, w0); pb[2 + s2] = __builtin_bit_cast(bf16x8, w1);
        }
        const LAS unsigned char* vt = Vl + 256 * 64 * kt;
#pragma unroll
        for (int d0 = 0; d0 < 4; ++d0)
#pragma unroll
            for (int ks = 0; ks < 4; ++ks) {
                const LAS unsigned char* vp = vt + vb[d0] + 256 * 16 * ks;
                const s16x4 lo4 = __builtin_bit_cast(s16x4, __builtin_amdgcn_ds_read_tr16_b64_v4i16((LAS s16x4*)(vp)));
                const s16x4 hi4 = __builtin_bit_cast(s16x4, __builtin_amdgcn_ds_read_tr16_b64_v4i16((LAS s16x4*)(vp + 256 * 8)));
                const bf16x8 va = __builtin_shufflevector(lo4, hi4, 0, 1, 2, 3, 4, 5, 6, 7);
                o[d0] = __builtin_amdgcn_mfma_f32_32x32x16_bf16(va, pb[ks], o[d0], 0, 0, 0);
            }
    }
    m_out = m; l_out = l;
}

__device__ __forceinline__ void p3_attention(Frame& F, int cw_item) {
    const int lane = hw_lane(), tid = F.wave * 64 + lane;
    LAS unsigned char* Kl = F.lds; LAS unsigned char* Vl = F.lds + 65536;
    LAS float* lut = (LAS float*)(F.lds + ATT_LUT_OFF);
    LAS int* misc = (LAS int*)(F.lds + ATT_MISC_OFF);
    const int r32 = lane & 31, hi = lane >> 5;
    const int NITEMS = N_ITEMS_PER_HEAD * NH;
    for (;;) {
        if (tid == 0) misc[0] = (int)__hip_atomic_fetch_add(F.ctl + cw_item, 1u, RLX_AGENT);
        LDS_WAIT(); __syncthreads();
        const int item = __builtin_amdgcn_readfirstlane(misc[0]);
        if (item >= NITEMS) break;
        const int h = item & 15, e = item >> 4;
        int j, lo, hq, own; item_decode(e, j, lo, hq, own);
        const int nsub = hq - lo;
        {
            const bf16_t* kg = F.PROJ + (size_t)(j * BLK) * PW + COL_K + h * HD; const bf16_t* vg = F.PROJ + (size_t)(j * BLK) * PW + COL_V + h * HD;
            u32x4 kv[8], vv[8];
#pragma unroll
            for (int i = 0; i < 8; ++i) { const int p = tid + 512 * i, row = p >> 4, ch = p & 15; kv[i] = *(const u32x4*)(kg + (size_t)row * PW + 8 * ch); vv[i] = *(const u32x4*)(vg + (size_t)row * PW + 8 * ch); }
#pragma unroll
            for (int i = 0; i < 8; ++i) { const int p = tid + 512 * i, row = p >> 4, ch = p & 15;
                *(LAS u32x4*)(Kl + 256 * row + ((16 * ch) ^ ((row & 15) << 4))) = kv[i];
                *(LAS u32x4*)(Vl + 256 * row + 16 * (ch ^ ((row & 3) << 2))) = vv[i]; }
        }
        for (int i = tid; i < 768; i += 512) {
            const int dist = i - 255; float v;
            if (dist < 0) v = -INFINITY;
            else { int b; if (dist < 16) b = dist; else { b = 16 + (int)(logf((float)dist * (1.f / 16.f)) / logf(8.f) * 16.f); b = b > 31 ? 31 : b; }
                   v = F.rel_bias[b * NH + h] * LOG2E; }
            lut[i] = v;
        }
        if (tid == 0) { int acc = own ? BLK : 0; misc[8] = acc; for (int k = 0; k < nsub; ++k) { acc += F.CNT[((size_t)h * NB + j) * NB + lo + k]; misc[9 + k] = acc; } }
        LDS_WAIT(); __syncthreads();
        const int nown = own ? BLK : 0;
        const int total = misc[8 + nsub];
        const float c31 = F.rel_bias[31 * NH + h] * LOG2E;
        const int NT = (total + 31) >> 5;
        for (int t = F.wave; t < NT; t += NWAVES) {
            const int e0 = 32 * t + r32; const bool valid = e0 < total; const int ee = valid ? e0 : total - 1;
            int qb, ql, slot;
            if (ee < nown) { qb = j; ql = ee; slot = 3; }
            else {
                int k = 0;
#pragma unroll
                for (int kk = 1; kk < 8; ++kk) if (kk < nsub && ee >= misc[8 + kk]) k = kk;
                qb = lo + k; const unsigned ent = F.LIST[(((size_t)h * NB + j) * NB + qb) * BLK + (ee - misc[8 + k])]; ql = ent & 255; slot = ent >> 8;
            }
            const int s = qb * BLK + ql; const int dbase = (qb - j) * BLK + ql; const int dbc = dbase < 511 ? dbase : 511;
            const bool own_tile = (32 * t) < nown;
            const int nkt = own_tile ? ((t >> 1) + 1) : 4;
            bf16x8 qr[8];
            const bf16_t* qp = F.PROJ + (size_t)s * PW + COL_Q + h * HD + 8 * hi;
#pragma unroll
            for (int st = 0; st < 8; ++st) qr[st] = *(const bf16x8*)(qp + 16 * st);
            f32x16 o[4]; float m, l;
            const bool general = !__all(dbase >= 368);
            if (general) att_tile<true>(Kl, Vl, lut + (dbc + 255 - 4 * hi), c31, nkt, qr, r32, hi, lane, m, l, o);
            else att_tile<false>(Kl, Vl, lut, c31, nkt, qr, r32, hi, lane, m, l, o);
            { auto rr = __builtin_amdgcn_permlane32_swap(__float_as_uint(l), __float_as_uint(l), false, false); l = __uint_as_float(rr[0]) + __uint_as_float(rr[1]); }
            const float inv = 1.0f / l;
            if (valid) {
                bf16_t* op = F.PART + (((size_t)s * NH + h) * 4 + slot) * HD + 4 * hi;
#pragma unroll
                for (int d0 = 0; d0 < 4; ++d0)
#pragma unroll
                    for (int g = 0; g < 4; ++g) { u32x2 w; w.x = cvtpk(o[d0][4 * g] * inv, o[d0][4 * g + 1] * inv); w.y = cvtpk(o[d0][4 * g + 2] * inv, o[d0][4 * g + 3] * inv); *(u32x2*)(op + 32 * d0 + 8 * g) = w; }
                if (hi == 0) F.LSE[((size_t)s * NH + h) * 4 + slot] = m + __log2f(l);
            }
        }
        __syncthreads();
    }
}

__device__ __forceinline__ void p4_mix(Frame& F) {
    const int lane = hw_lane(), tid = F.wave * 64 + lane;
    const int gt = F.vcu * 512 + tid, NT = F.G * 512;
    for (int idx = gt; idx < SEQ * NH * 16; idx += NT) {
        const int c = idx & 15, h = (idx >> 4) & 15, s = idx >> 8; const int qb = s >> 8, nv = qb < 3 ? qb : 3;
        const f32x4 L = *(const f32x4*)(F.LSE + ((size_t)s * NH + h) * 4);
        float M = L[3]; for (int r = 0; r < 3; ++r) if (r < nv) M = fmaxf(M, L[r]);
        float w[4]; float ws = 0.f;
        for (int r = 0; r < 3; ++r) { w[r] = (r < nv) ? __builtin_amdgcn_exp2f(L[r] - M) : 0.f; ws += w[r]; }
        w[3] = __builtin_amdgcn_exp2f(L[3] - M); ws += w[3];
        const float inv = 1.0f / ws;
        float acc[8] = {0.f, 0.f, 0.f, 0.f, 0.f, 0.f, 0.f, 0.f};
        const bf16_t* pp = F.PART + (((size_t)s * NH + h) * 4) * HD + 8 * c;
#pragma unroll
        for (int r = 0; r < 4; ++r) if (r == 3 || r < nv) { const u32x4 v = *(const u32x4*)(pp + r * HD); const float wr_ = w[r] * inv;
            acc[0] += wr_ * bf_lo(v.x); acc[1] += wr_ * bf_hi(v.x); acc[2] += wr_ * bf_lo(v.y); acc[3] += wr_ * bf_hi(v.y);
            acc[4] += wr_ * bf_lo(v.z); acc[5] += wr_ * bf_hi(v.z); acc[6] += wr_ * bf_lo(v.w); acc[7] += wr_ * bf_hi(v.w); }
        const u32x4 z = *(const u32x4*)(F.PROJ + (size_t)s * PW + COL_ZA + h * HD + 8 * c);
        u32x4 o;
        o.x = cvtpk(acc[0] * silu_f(bf_lo(z.x)), acc[1] * silu_f(bf_hi(z.x))); o.y = cvtpk(acc[2] * silu_f(bf_lo(z.y)), acc[3] * silu_f(bf_hi(z.y)));
        o.z = cvtpk(acc[4] * silu_f(bf_lo(z.z)), acc[5] * silu_f(bf_hi(z.z))); o.w = cvtpk(acc[6] * silu_f(bf_lo(z.w)), acc[7] * silu_f(bf_hi(z.w)));
        *(u32x4*)(F.MIX + (size_t)s * DM + h * HD + 8 * c) = o;
    }
    for (int idx = gt; idx < SEQ * 256; idx += NT) {
        const int c8 = idx & 255, s = idx >> 8, ch = 8 * c8;
        float t[3][8];
#pragma unroll
        for (int k = 0; k < 3; ++k) {
            const int sp = s - 2 + k;
            if (sp >= 0) { const u32x4 hv = *(const u32x4*)(F.PROJ + (size_t)sp * PW + COL_HC + ch), cv = *(const u32x4*)(F.PROJ + (size_t)sp * PW + COL_CG + ch);
                t[k][0] = bf_lo(hv.x) * bf_lo(cv.x); t[k][1] = bf_hi(hv.x) * bf_hi(cv.x); t[k][2] = bf_lo(hv.y) * bf_lo(cv.y); t[k][3] = bf_hi(hv.y) * bf_hi(cv.y);
                t[k][4] = bf_lo(hv.z) * bf_lo(cv.z); t[k][5] = bf_hi(hv.z) * bf_hi(cv.z); t[k][6] = bf_lo(hv.w) * bf_lo(cv.w); t[k][7] = bf_hi(hv.w) * bf_hi(cv.w); }
            else { for (int e = 0; e < 8; ++e) t[k][e] = 0.f; }
        }
        const u32x4 bv = *(const u32x4*)(F.PROJ + (size_t)s * PW + COL_BG + ch), zv = *(const u32x4*)(F.PROJ + (size_t)s * PW + COL_ZC + ch);
        const float bg[8] = {bf_lo(bv.x), bf_hi(bv.x), bf_lo(bv.y), bf_hi(bv.y), bf_lo(bv.z), bf_hi(bv.z), bf_lo(bv.w), bf_hi(bv.w)};
        const float zc[8] = {bf_lo(zv.x), bf_hi(zv.x), bf_lo(zv.y), bf_hi(zv.y), bf_lo(zv.z), bf_hi(zv.z), bf_lo(zv.w), bf_hi(zv.w)};
        float y[8];
#pragma unroll
        for (int e = 0; e < 8; ++e) { const float w0 = F.conv_w[ch + e], w1 = F.conv_w[2048 + ch + e], w2 = F.conv_w[4096 + ch + e];
            y[e] = bg[e] * (t[0][e] * w0 + t[1][e] * w1 + t[2][e] * w2) * silu_f(zc[e]); }
        u32x4 o; o.x = cvtpk(y[0], y[1]); o.y = cvtpk(y[2], y[3]); o.z = cvtpk(y[4], y[5]); o.w = cvtpk(y[6], y[7]);
        *(u32x4*)(F.MIX + (size_t)s * DM + AW + ch) = o;
    }
}

__device__ __forceinline__ void p6_final(Frame& F) {
    const int lane = hw_lane(), tid = F.wave * 64 + lane;
    const int gw = F.vcu * NWAVES + F.wave, NGW = F.G * NWAVES;
    for (int row = gw; row < SEQ; row += NGW) {
        const float ss = wave_sum(F.ROWSS[(size_t)row * 64 + lane]);
        const float rstd = 1.0f / sqrtf(ss * (1.f / DM) + EPS);
        f32x4* orow = (f32x4*)(F.out + (size_t)row * DM) + lane; const f32x4* gr = (const f32x4*)F.fg + lane;
        f32x4 v[16];
#pragma unroll
        for (int j = 0; j < 16; ++j) v[j] = orow[64 * j];
#pragma unroll
        for (int j = 0; j < 16; ++j) { const f32x4 g = gr[64 * j]; f32x4 r; r[0] = v[j][0] * rstd * g[0]; r[1] = v[j][1] * rstd * g[1]; r[2] = v[j][2] * rstd * g[2]; r[3] = v[j][3] * rstd * g[3]; orow[64 * j] = r; }
    }
}

struct Args { const float* x; const float* ng; const float* w_in; const float* conv_w; const float* w_out; const float* rel_bias; const float* fg; float* out; unsigned char* ws; int ph_lo, ph_hi; };
__global__ void __launch_bounds__(NWAVES * 64, 2) mk_fwd(Args args) {
    extern __shared__ __attribute__((aligned(16))) unsigned char lds[];
    Frame F;
    F.lds = (LAS unsigned char*)lds;
    F.MISC = (volatile LAS unsigned*)(F.lds + MISC_OFF);
    F.wave = __builtin_amdgcn_readfirstlane((int)(threadIdx.x >> 6));
    F.G = gridDim.x; { const int bx = blockIdx.x; F.vcu = (F.G % 8 == 0) ? (bx % 8) * (F.G / 8) + bx / 8 : bx; }
    unsigned char* ws = args.ws;
    F.ctl = (unsigned*)(ws + WS_CTL);
    F.x = args.x; F.ng = args.ng; F.w_in = args.w_in; F.conv_w = args.conv_w; F.w_out = args.w_out; F.rel_bias = args.rel_bias; F.fg = args.fg; F.out = args.out;
    F.WinT = (bf16_t*)(ws + WS_WIN); F.WoutT = (bf16_t*)(ws + WS_WOUT); F.U = (bf16_t*)(ws + WS_U); F.PROJ = (bf16_t*)(ws + WS_PROJ); F.MIX = (bf16_t*)(ws + WS_MIX); F.PART = (bf16_t*)(ws + WS_PART);
    F.W8 = ws + WS_W8; F.U8 = ws + WS_U8;
    F.LSE = (float*)(ws + WS_LSE); F.KSUM = (float*)(ws + WS_KSUM); F.ROWSS = (float*)(ws + WS_ROWSS); F.LIST = (unsigned short*)(ws + WS_LIST); F.CNT = (int*)(ws + WS_CNT);
    for (int u = threadIdx.x; u < (LDS_BYTES - LDSCTL_OFF) / 4; u += NWAVES * 64) ((LAS unsigned*)(F.lds + LDSCTL_OFF))[u] = 0u;
    __syncthreads();
    XcdBarrier bar; bar.bar = F.ctl + CW_BAR; bar.x = 0; bar.st = nullptr;
    if (N_LAUNCHES == 1) bar = xcd_barrier_post(F.ctl + CW_BAR, F.MISC + 8);
#define GRID_BAR() do { if (N_LAUNCHES == 1) xcd_barrier(bar); } while (0)
    const int lo = args.ph_lo, hi = args.ph_hi;
#define IN(k) (lo <= (k) && (k) < hi)
#define BOTH(k) (IN(k) && IN((k) + 1))
    if (IN(0)) { p0_prologue(F); if (MK_DOUBLE == 0) { GRID_BAR(); p0_prologue(F); } if (BOTH(0)) GRID_BAR(); }
    if (IN(1)) {
        {
            pg8::Gemm g{F.U8, F.W8, SEQ, 8192, DM}; pg8::StaticOrder S; S.init(SEQ, 8192, F.G, (int)blockIdx.x);
            pg8::EpiProj E{F.PROJ, PW, F.KSUM};
            pg8::gemm_phase<pg8::EpiProj, pg8::StaticOrder, true, true, true>(F.lds, g, S, E, F.wave);
        }
        {
            pg8::Gemm g{F.U, F.WinT + (size_t)8192 * DM, SEQ, 8192, DM}; pg8::StaticOrder S; S.init(SEQ, 8192, F.G, (int)blockIdx.x);
            pg8::EpiProj E{F.PROJ + COL_HC, PW, nullptr};
            pg8::gemm_phase<pg8::EpiProj, pg8::StaticOrder, true, true, false>(F.lds, g, S, E, F.wave);
        }
        if (BOTH(1)) GRID_BAR();
    }
    if (IN(2)) { p2_route(F); if (MK_DOUBLE == 2) { GRID_BAR(); p2_route(F); } if (BOTH(2)) GRID_BAR(); }
    if (IN(3)) { p3_attention(F, CW_ITEM); if (MK_DOUBLE == 3) { GRID_BAR(); p3_attention(F, CW_ITEM + 64); } if (BOTH(3)) GRID_BAR(); }
    if (IN(4)) { p4_mix(F); if (MK_DOUBLE == 4) { GRID_BAR(); p4_mix(F); } if (BOTH(4)) GRID_BAR(); }
    if (IN(5)) {
        pg8::Gemm g{F.MIX, F.WoutT, SEQ, DM, DM}; pg8::StaticOrder S; S.init(SEQ, DM, F.G, (int)blockIdx.x);
        pg8::EpiOut E{F.x, F.out, F.ROWSS};
        pg8::gemm_phase<pg8::EpiOut, pg8::StaticOrder, true, true>(F.lds, g, S, E, F.wave);
        if (MK_DOUBLE == 5) { GRID_BAR(); pg8::gemm_phase<pg8::EpiOut, pg8::StaticOrder, true, true>(F.lds, g, S, E, F.wave); }
        if (BOTH(5)) GRID_BAR();
    }
    if (IN(6)) { p6_final(F); }
#undef IN
#undef BOTH
}

extern "C" void kernel_launch(void* const* d_in, const int* in_sizes, int n_in, void* d_out, int out_size, void* d_ws, size_t ws_size, hipStream_t stream) {
    static int grid = 0;
    if (grid == 0) {
        if (n_in != 7 || in_sizes[0] != SEQ * DM || out_size != SEQ * DM || ws_size < WS_END) {
            fprintf(stderr, "kernel_launch: unexpected shapes (n_in %d, in0 %d, out %d, ws %zu); nothing launched\n", n_in, n_in > 0 ? in_sizes[0] : -1, out_size, ws_size); grid = -1; return; }
        int dev = 0, cus = 0, per_cu = 0;
        if (hipGetDevice(&dev) != hipSuccess || hipDeviceGetAttribute(&cus, hipDeviceAttributeMultiprocessorCount, dev) != hipSuccess) { fprintf(stderr, "kernel_launch: device query failed\n"); grid = -1; return; }
        if (hipFuncSetAttribute((const void*)mk_fwd, hipFuncAttributeMaxDynamicSharedMemorySize, LDS_BYTES) != hipSuccess) { fprintf(stderr, "kernel_launch: hipFuncSetAttribute failed\n"); grid = -1; return; }
        if (hipOccupancyMaxActiveBlocksPerMultiprocessor(&per_cu, (const void*)mk_fwd, NWAVES * 64, LDS_BYTES) != hipSuccess || per_cu < 1) {
            fprintf(stderr, "kernel_launch: occupancy query reports %d workgroups per CU\n", per_cu); (void)hipGetLastError(); grid = -1; return; }
        grid = cus;
    }
    if (grid < 0) return;
    (void)hipMemsetAsync((char*)d_ws + WS_CTL, 0, CTL_ZERO_BYTES, stream);
    Args a{};
    a.x = (const float*)d_in[0]; a.ng = (const float*)d_in[1]; a.w_in = (const float*)d_in[2]; a.conv_w = (const float*)d_in[3]; a.w_out = (const float*)d_in[4];
    a.rel_bias = (const float*)d_in[5]; a.fg = (const float*)d_in[6]; a.out = (float*)d_out; a.ws = (unsigned char*)d_ws;
    if (N_LAUNCHES == 1) { a.ph_lo = 0; a.ph_hi = N_PHASES; hipLaunchKernelGGL(mk_fwd, dim3(grid), dim3(NWAVES * 64), LDS_BYTES, stream, a); }
    else { for (int p = 0; p < N_PHASES; ++p) { a.ph_lo = p; a.ph_hi = p + 1; hipLaunchKernelGGL(mk_fwd, dim3(grid), dim3(NWAVES * 64), LDS_BYTES, stream, a); } }
}
```

```cpp
#include <hip/hip_runtime.h>
#include <cstdio>
#include <cstdint>
#include <cmath>

#ifndef MK_DOUBLE
#define MK_DOUBLE -1
#endif
#ifndef MK_N_LAUNCHES
#define MK_N_LAUNCHES 1
#endif

#define LAS __attribute__((address_space(3)))
#define GAS __attribute__((address_space(1)))
typedef unsigned short bf16_t;
typedef short bf16x8 __attribute__((ext_vector_type(8)));
typedef short s16x4 __attribute__((ext_vector_type(4)));
typedef float f32x4 __attribute__((ext_vector_type(4)));
typedef float f32x16 __attribute__((ext_vector_type(16)));
typedef unsigned u32x4 __attribute__((ext_vector_type(4)));
typedef unsigned u32x2 __attribute__((ext_vector_type(2)));
typedef float f32x2_t __attribute__((ext_vector_type(2)));
typedef __bf16 bf16x2_t __attribute__((ext_vector_type(2)));

constexpr int HSQ = 8192 + 16;
constexpr int SEQ = 8192, DM = 4096, PW = 16384, AW = 2048, NH = 16, HD = 128, BLK = 256, NB = 32;
constexpr int COL_Q = 0, COL_K = 2048, COL_V = 4096, COL_ZA = 6144, COL_HC = 8192, COL_BG = 10240, COL_CG = 12288, COL_ZC = 14336;
constexpr float EPS = 1e-6f;
constexpr float LOG2E = 1.4426950408889634f;
constexpr float QK_C = 0.08838834764831845f * LOG2E / 8.f;

__device__ __forceinline__ unsigned cvtpk(float lo, float hi) { f32x2_t v = {lo, hi}; bf16x2_t b = __builtin_convertvector(v, bf16x2_t); return __builtin_bit_cast(unsigned, b); }
__device__ __forceinline__ float bf_lo(unsigned w) { return __uint_as_float(w << 16); }
__device__ __forceinline__ float bf_hi(unsigned w) { return __uint_as_float(w & 0xffff0000u); }
__device__ __forceinline__ float silu_f(float z) { return z * __builtin_amdgcn_rcpf(1.f + __builtin_amdgcn_exp2f(-LOG2E * z)); }
__device__ __forceinline__ int hw_lane() { int l; asm volatile("v_mbcnt_lo_u32_b32 %0, -1, 0\n\tv_mbcnt_hi_u32_b32 %0, -1, %0" : "=v"(l)); return l; }
__device__ __forceinline__ int crow(int r, int hi) { return (r & 3) + 8 * (r >> 2) + 4 * hi; }

namespace pg8 {
#define PG8_LAS __attribute__((address_space(3)))
__device__ __forceinline__ void glds16s(const void* sbase, unsigned voff, unsigned lds_dst) {
    unsigned keep;
    asm volatile("s_mov_b32 %0, m0\n\ts_mov_b32 m0, %3\n\ts_nop 0\n\tglobal_load_lds_dwordx4 %1, %2\n\ts_mov_b32 m0, %0" : "=&s"(keep) : "v"(voff), "s"(sbase), "s"(lds_dst) : "memory");
}
constexpr int BM = 256, BK = 64, HALF = 128, HTB = HALF * BK * 2, STAGE_BYTES = 8 * HTB, NXCD = 8, WGM = 8;
__host__ __device__ __forceinline__ int lds_byte(int r, int c) { const int st = (r >> 4) * 2 + (c >> 5), rr = r & 15, cc = c & 31, ob = rr * 64 + cc * 2; return st * 1024 + (ob ^ (((ob >> 9) & 1) << 5)); }
__host__ __device__ __forceinline__ void stage_rc(int b, int& R, int& C) { const int st = b / 1024, sb = b % 1024, swz = sb ^ (((sb >> 9) & 1) << 5); R = (st >> 1) * 16 + swz / 64; C = (st & 1) * 32 + (swz % 64) / 2; }
__host__ __device__ __forceinline__ int perm32(int rho) { const int n = rho >> 4, i = rho & 15; return 8 * (i >> 2) + 4 * n + (i & 3); }

struct Unit { int pm, pn; };
struct Gemm { const void* A; const void* Bt; int M, N, pitch, nt; };

struct StaticOrder {
    int nM, nN, nwg, G, c, skip_from, skip_by;
    __host__ __device__ void init(int M, int N, int G_, int c_, int sf = 1 << 30, int sb = 0) { nM = M / BM; nN = N / BM; nwg = nM * nN; G = G_; c = c_; skip_from = sf; skip_by = sb; }
    __host__ __device__ bool next(int i, Unit& u) const {
        const long L = (long)i * G + c; if (L >= nwg) return false;
        int wgid = (int)L; { const int q = nwg / NXCD, r = nwg % NXCD, xcd = wgid % NXCD, off = wgid / NXCD; wgid = (xcd < r ? xcd * (q + 1) : r * (q + 1) + (xcd - r) * q) + off; }
        const int nig = WGM * nN, gid = wgid / nig, fm = gid * WGM, gsz = (nM - fm) < WGM ? (nM - fm) : WGM;
        u.pm = fm + ((wgid % nig) % gsz); u.pn = (wgid % nig) / gsz; if (u.pn >= skip_from) u.pn += skip_by; return true;
    }
    __device__ __forceinline__ void a_ready(const Unit&) const {}
    __device__ __forceinline__ void done(const Unit&) const {}
};

struct EpiProj {
    static constexpr int PERM = 2; static constexpr bool AFTER_DRAIN = false;
    bf16_t* O; int ldc; float* ksum; unsigned char* O8;
    __device__ __forceinline__ void operator()(const f32x4 (&acc)[2][2][4][2], const Unit& u, int wr, int wc, int fr, int fq) const {
        const int row0 = u.pm * BM + wr * 64 + fr; const int col0 = u.pn * BM + wc * 64 + 16 * fq;
        if (u.pn < 8) {
#pragma unroll
        for (int ai = 0; ai < 2; ++ai)
#pragma unroll
            for (int m = 0; m < 4; ++m) { bf16_t* rowp = O + ((size_t)(col0 >> 7) * HSQ + (row0 + ai * HALF + m * 16)) * 128 + (col0 & 127);
#pragma unroll
                for (int bj = 0; bj < 2; ++bj) { const f32x4 v0 = acc[ai][bj][m][0], v1 = acc[ai][bj][m][1];
                    u32x4 w; w.x = cvtpk(v0[0], v0[1]); w.y = cvtpk(v0[2], v0[3]); w.z = cvtpk(v1[0], v1[1]); w.w = cvtpk(v1[2], v1[3]);
                    *(u32x4*)(rowp + bj * 8) = w; } }
        } else {
#define F8C(x) __builtin_amdgcn_fmed3f((x) * 8.f, -448.f, 448.f)
#pragma unroll
        for (int ai = 0; ai < 2; ++ai)
#pragma unroll
            for (int m = 0; m < 4; ++m) { unsigned char* rowp = O8 + ((size_t)((col0 - 2048) >> 7) * HSQ + (row0 + ai * HALF + m * 16)) * 128 + (col0 & 127); u32x4 w;
#pragma unroll
                for (int bj = 0; bj < 2; ++bj) { const f32x4 v0 = acc[ai][bj][m][0], v1 = acc[ai][bj][m][1];
                    int w0 = __builtin_amdgcn_cvt_pk_fp8_f32(F8C(v0[0]), F8C(v0[1]), 0, false); w0 = __builtin_amdgcn_cvt_pk_fp8_f32(F8C(v0[2]), F8C(v0[3]), w0, true);
                    int w1 = __builtin_amdgcn_cvt_pk_fp8_f32(F8C(v1[0]), F8C(v1[1]), 0, false); w1 = __builtin_amdgcn_cvt_pk_fp8_f32(F8C(v1[2]), F8C(v1[3]), w1, true);
                    w[2 * bj] = (unsigned)w0; w[2 * bj + 1] = (unsigned)w1; }
                *(u32x4*)rowp = w; }
#undef F8C
        }
        if (ksum && u.pn >= 8 && u.pn < 16) {
            float* kp = ksum + (size_t)u.pm * 2048 + (u.pn - 8) * BM + wc * 64 + 16 * fq;
#pragma unroll
            for (int bj = 0; bj < 2; ++bj)
#pragma unroll
                for (int n = 0; n < 2; ++n) {
                    f32x4 s = acc[0][bj][0][n];
#pragma unroll
                    for (int m = 1; m < 4; ++m) s += acc[0][bj][m][n];
#pragma unroll
                    for (int m = 0; m < 4; ++m) s += acc[1][bj][m][n];
#pragma unroll
                    for (int j = 0; j < 4; ++j) { float v = s[j]; v += __shfl_xor(v, 1); v += __shfl_xor(v, 2); v += __shfl_xor(v, 4); v += __shfl_xor(v, 8);
                        if (fr == 0) atomicAdd(kp + 8 * bj + 4 * n + j, v); }
                }
        }
    }
};
template <int CTRL> __device__ __forceinline__ float dpp1(float v) { return __builtin_bit_cast(float, __builtin_amdgcn_update_dpp(0, __builtin_bit_cast(int, v), CTRL, 0xf, 0xf, false)); }
template <int CTRL> __device__ __forceinline__ f32x4 dpp_ror(const f32x4 v) { f32x4 r; r.x = dpp1<CTRL>(v.x); r.y = dpp1<CTRL>(v.y); r.z = dpp1<CTRL>(v.z); r.w = dpp1<CTRL>(v.w); return r; }
struct EpiConv {
    static constexpr bool PERM = true, AFTER_DRAIN = false;
    bf16_t* MIXp; const float* cw; float* TH; float* BZT;
    __device__ __forceinline__ void operator()(const f32x4 (&acc)[2][2][4][2], const Unit& u, int wr, int wc, int fr, int fq) const {
        const int ch = u.pn * 64 + wc * 16 + fq * 4;
        const f32x4 w0 = *(const f32x4*)(cw + ch), w1 = *(const f32x4*)(cw + 2048 + ch), w2 = *(const f32x4*)(cw + 4096 + ch);
#pragma unroll
        for (int ai = 0; ai < 2; ++ai) {
            const int strip = u.pm * 4 + ai * 2 + wr;
            f32x4 t[4], r1[4], r2[4];
#pragma unroll
            for (int m = 0; m < 4; ++m) { t[m] = acc[ai][1][m][0] * acc[ai][0][m][0]; r1[m] = dpp_ror<0x121>(t[m]); r2[m] = dpp_ror<0x122>(t[m]); }
#pragma unroll
            for (int m = 0; m < 4; ++m) {
                const f32x4 p1 = m ? r1[m - 1] : (f32x4){0.f, 0.f, 0.f, 0.f}, p2 = m ? r2[m - 1] : (f32x4){0.f, 0.f, 0.f, 0.f};
                f32x4 t1, t2;
#pragma unroll
                for (int j = 0; j < 4; ++j) { t1[j] = fr == 0 ? p1[j] : r1[m][j]; t2[j] = fr < 2 ? p2[j] : r2[m][j]; }
                const f32x4 y = w0 * t2 + w1 * t1 + w2 * t[m]; const f32x4 bg = acc[ai][0][m][1], z = acc[ai][1][m][1];
                u32x2 o; o.x = cvtpk(bg[0] * y[0] * silu_f(z[0]), bg[1] * y[1] * silu_f(z[1])); o.y = cvtpk(bg[2] * y[2] * silu_f(z[2]), bg[3] * y[3] * silu_f(z[3]));
                if (m != 0 || fr >= 2) *(u32x2*)(MIXp + (size_t)(strip * 64 + m * 16 + fr) * DM + AW + ch) = o;
            }
            if (fr >= 14) *(f32x4*)(TH + ((size_t)strip * 2 + (fr - 14)) * 2048 + ch) = t[3];
            if (fr < 2) { float* bz = BZT + (((size_t)strip * 2 + fr) * 3) * 2048 + ch; *(f32x4*)(bz) = acc[ai][0][0][1]; *(f32x4*)(bz + 2048) = acc[ai][1][0][1]; *(f32x4*)(bz + 4096) = t[0]; }
        }
    }
};
struct EpiOut {
    static constexpr bool PERM = false, AFTER_DRAIN = false;
    const float* X; float* out; float* rowss;
    __device__ __forceinline__ void operator()(const f32x4 (&acc)[2][2][4][2], const Unit& u, int wr, int wc, int fr, int fq) const {
        const int col0 = u.pn * BM + wc * 32 + 4 * fq;
#pragma unroll
        for (int ai = 0; ai < 2; ++ai)
#pragma unroll
            for (int m = 0; m < 4; ++m) { const int row = u.pm * BM + ai * HALF + wr * 64 + m * 16 + fr; const size_t off = (size_t)row * DM + col0; float ss = 0.f;
#pragma unroll
                for (int bj = 0; bj < 2; ++bj)
#pragma unroll
                    for (int n = 0; n < 2; ++n) { const f32x4 xv = *(const f32x4*)(X + off + bj * HALF + n * 16); const f32x4 hv = xv + acc[ai][bj][m][n];
                        *(f32x4*)(out + off + bj * HALF + n * 16) = hv; ss += (hv[0] * hv[0] + hv[1] * hv[1]) + (hv[2] * hv[2] + hv[3] * hv[3]); }
                ss += __shfl_xor(ss, 16); ss += __shfl_xor(ss, 32);
                if (fq == 0) rowss[(size_t)row * 64 + u.pn * 4 + wc] = ss; }
    }
};

constexpr int F8_SCALE_W = 0x78787878, F8_SCALE_U = 0x7D7D7D7D;
typedef int v4i_t __attribute__((ext_vector_type(4)));
typedef int v8i_t __attribute__((ext_vector_type(8)));
struct OneUnit { Unit u;
    __device__ __forceinline__ bool next(int i, Unit& o) const { if (i != 0) return false; o = u; return true; }
    __device__ __forceinline__ void a_ready(const Unit&) const {}
    __device__ __forceinline__ void done(const Unit&) const {}
};
struct EpiOutNorm {
    static constexpr bool PERM = false, AFTER_DRAIN = true;
    const float* X; float* out; float* rowss; const float* fg; unsigned* cnt; unsigned* tmo; int pn0; bf16_t* H0; unsigned target;
    __device__ __forceinline__ bf16_t* h0_piece(int pm, int pn, int wr, int wc, int fr, int fq) const { return H0 + ((size_t)(pm * 16 + pn) << 16) + ((wr * 4 + wc) << 13) + ((fq * 16 + fr) << 3); }
    __device__ __forceinline__ void tile_h(f32x4 (&acc)[2][2][4][2], const Unit& u, int wr, int wc, int fr, int fq, bool store) const {
        const int col0 = u.pn * BM + wc * 32 + 4 * fq;
#pragma unroll
        for (int ai = 0; ai < 2; ++ai) {
            const int row0 = u.pm * BM + ai * HALF + wr * 64 + fr;
            f32x4 xv[4][2][2];
#pragma unroll
            for (int m = 0; m < 4; ++m)
#pragma unroll
                for (int bj = 0; bj < 2; ++bj)
#pragma unroll
                    for (int n = 0; n < 2; ++n) xv[m][bj][n] = __builtin_nontemporal_load((const f32x4*)(X + (size_t)(row0 + m * 16) * DM + col0 + bj * HALF + n * 16));
            asm volatile("" ::: "memory");
            float ssv[4];
#pragma unroll
            for (int m = 0; m < 4; ++m) { float ss = 0.f;
#pragma unroll
                for (int bj = 0; bj < 2; ++bj) { u32x4 hb;
#pragma unroll
                    for (int n = 0; n < 2; ++n) { const f32x4 hv = xv[m][bj][n] + acc[ai][bj][m][n]; acc[ai][bj][m][n] = hv;
                        hb[2 * n] = cvtpk(hv[0], hv[1]); hb[2 * n + 1] = cvtpk(hv[2], hv[3]); ss += (hv[0] * hv[0] + hv[1] * hv[1]) + (hv[2] * hv[2] + hv[3] * hv[3]); }
                    if (store) *(u32x4*)(h0_piece(u.pm, u.pn, wr, wc, fr, fq) + (((ai * 4 + m) * 2 + bj) << 9)) = hb; }
                ss += __shfl_xor(ss, 16); ss += __shfl_xor(ss, 32); ssv[m] = ss; }
            if (fq == 0) {
#pragma unroll
                for (int m = 0; m < 4; ++m) __hip_atomic_store(rowss + (size_t)(row0 + m * 16) * 64 + u.pn * 4 + wc, ssv[m], __ATOMIC_RELAXED, __HIP_MEMORY_SCOPE_AGENT); }
            asm volatile("" ::: "memory");
        }
    }
    __device__ __forceinline__ void operator()(const f32x4 (&acc)[2][2][4][2], const Unit& u, int wr, int wc, int fr, int fq) const {
        f32x4 (&a)[2][2][4][2] = const_cast<f32x4 (&)[2][2][4][2]>(acc);
        tile_h(a, u, wr, wc, fr, fq, true);
    }
    __device__ __forceinline__ void fused(f32x4 (&acc)[2][2][4][2], const Unit& u, int wr, int wc, int fr, int fq, PG8_LAS unsigned char* lds, int wid, int lane) const {
        PG8_LAS float* S = (PG8_LAS float*)lds;
        PG8_LAS unsigned* flag = (PG8_LAS unsigned*)(lds + 2048);
        tile_h(acc, u, wr, wc, fr, fq, false);
        asm volatile("s_waitcnt vmcnt(0)" ::: "memory");
        __builtin_amdgcn_s_barrier(); asm volatile("" ::: "memory");
        unsigned* c = cnt + 64 * u.pm;
        if (wid == 0) {
            if (lane == 0) __hip_atomic_fetch_add(c, 1u, __ATOMIC_RELAXED, __HIP_MEMORY_SCOPE_AGENT);
            unsigned spins = 0; bool dead = false;
            while ((unsigned)__builtin_amdgcn_readfirstlane((int)__hip_atomic_load(c, __ATOMIC_RELAXED, __HIP_MEMORY_SCOPE_AGENT)) < target) {
                __builtin_amdgcn_s_sleep(2);
                if (++spins > (1u << 22)) { dead = true; break; } }
            if (lane == 0) { flag[0] = dead ? 1u : 0u; if (dead) __hip_atomic_store(tmo, 1u, __ATOMIC_RELAXED, __HIP_MEMORY_SCOPE_AGENT); }
        }
        asm volatile("s_waitcnt vmcnt(0) lgkmcnt(0)" ::: "memory"); __builtin_amdgcn_s_barrier(); asm volatile("" ::: "memory");
        { const int tid = wid * 64 + lane, row = tid >> 1, hf = tid & 1; const float* rp = rowss + (size_t)(u.pm * BM + row) * 64 + 32 * hf; float s = 0.f;
          { f32x4 v0, v1, v2, v3, v4, v5, v6, v7;
            asm volatile("global_load_dwordx4 %0, %8, off sc1\n\tglobal_load_dwordx4 %1, %8, off offset:16 sc1\n\tglobal_load_dwordx4 %2, %8, off offset:32 sc1\n\tglobal_load_dwordx4 %3, %8, off offset:48 sc1\n\t"
                         "global_load_dwordx4 %4, %8, off offset:64 sc1\n\tglobal_load_dwordx4 %5, %8, off offset:80 sc1\n\tglobal_load_dwordx4 %6, %8, off offset:96 sc1\n\tglobal_load_dwordx4 %7, %8, off offset:112 sc1\n\t"
                         "s_waitcnt vmcnt(0)" : "=&v"(v0), "=&v"(v1), "=&v"(v2), "=&v"(v3), "=&v"(v4), "=&v"(v5), "=&v"(v6), "=&v"(v7) : "v"(rp) : "memory");
            s += (v0[0] + v0[1]) + (v0[2] + v0[3]); s += (v1[0] + v1[1]) + (v1[2] + v1[3]); s += (v2[0] + v2[1]) + (v2[2] + v2[3]); s += (v3[0] + v3[1]) + (v3[2] + v3[3]);
            s += (v4[0] + v4[1]) + (v4[2] + v4[3]); s += (v5[0] + v5[1]) + (v5[2] + v5[3]); s += (v6[0] + v6[1]) + (v6[2] + v6[3]); s += (v7[0] + v7[1]) + (v7[2] + v7[3]); }
          s += __shfl_xor(s, 1);
          if (hf == 0) S[row] = 1.0f / sqrtf(s * (1.f / DM) + 1e-6f); }
        asm volatile("s_waitcnt lgkmcnt(0)" ::: "memory"); __builtin_amdgcn_s_barrier(); asm volatile("" ::: "memory");
        {
            const int col0 = u.pn * BM + wc * 32 + 4 * fq;
            f32x4 g[2][2];
#pragma unroll
            for (int bj = 0; bj < 2; ++bj)
#pragma unroll
                for (int n = 0; n < 2; ++n) g[bj][n] = *(const f32x4*)(fg + col0 + bj * HALF + n * 16);
#pragma unroll
            for (int ai = 0; ai < 2; ++ai)
#pragma unroll
                for (int m = 0; m < 4; ++m) { const int r = ai * HALF + wr * 64 + m * 16 + fr; const float rs = S[r]; const size_t off = (size_t)(u.pm * BM + r) * DM + col0;
#pragma unroll
                    for (int bj = 0; bj < 2; ++bj)
#pragma unroll
                        for (int n = 0; n < 2; ++n) *(f32x4*)(out + off + bj * HALF + n * 16) = acc[ai][bj][m][n] * rs * g[bj][n]; }
        }
        asm volatile("" ::: "memory");
        if (pn0 >= 0) {
            const int col0 = pn0 * BM + wc * 32 + 4 * fq;
            u32x4 hb[2][4][2];
            const bf16_t* hp = h0_piece(u.pm, pn0, wr, wc, fr, fq);
#pragma unroll
            for (int ai = 0; ai < 2; ++ai)
#pragma unroll
                for (int m = 0; m < 4; ++m)
#pragma unroll
                    for (int bj = 0; bj < 2; ++bj) hb[ai][m][bj] = *(const u32x4*)(hp + (((ai * 4 + m) * 2 + bj) << 9));
            f32x4 g[2][2];
#pragma unroll
            for (int bj = 0; bj < 2; ++bj)
#pragma unroll
                for (int n = 0; n < 2; ++n) g[bj][n] = *(const f32x4*)(fg + col0 + bj * HALF + n * 16);
            asm volatile("" ::: "memory");
#pragma unroll
            for (int ai = 0; ai < 2; ++ai)
#pragma unroll
                for (int m = 0; m < 4; ++m) { const int r = ai * HALF + wr * 64 + m * 16 + fr; const float rs = S[r]; const size_t off = (size_t)(u.pm * BM + r) * DM + col0;
#pragma unroll
                    for (int bj = 0; bj < 2; ++bj)
#pragma unroll
                        for (int n = 0; n < 2; ++n) { const u32x4 h4 = hb[ai][m][bj]; const f32x4 hv = (f32x4){bf_lo(h4[2 * n]), bf_hi(h4[2 * n]), bf_lo(h4[2 * n + 1]), bf_hi(h4[2 * n + 1])};
                            *(f32x4*)(out + off + bj * HALF + n * 16) = hv * rs * g[bj][n]; } }
        }
    }
};
template <class Epi, class Sched, bool ALIGN_EPI = false, bool SP2 = false, bool F8 = false, int MIXK = 0>
__device__ __forceinline__ void gemm_phase(PG8_LAS unsigned char* lds, const Gemm g, const Sched& S, const Epi& E, int wid) {
    const int lane = hw_lane(), tid = wid * 64 + lane, wr = wid >> 2, wc = wid & 3, fr = lane & 15, fq = lane >> 4;
    const int pitch = g.pitch, nt = g.nt;
    constexpr int SCALE_A8 = MIXK > 0 ? 0x7B7B7B7B : F8_SCALE_U;
#define PG8_KOFS(t) ((size_t)(t) * 128 + ((MIXK > 0 && (t) >= MIXK) ? 2048 : 0))
    unsigned voffA[2], voffB[2];
#pragma unroll
    for (int i = 0; i < 2; ++i) { int R, C; stage_rc(tid * 16 + i * 8192, R, C); const int Rb = (int)Epi::PERM == 2 ? (64 * (R >> 5) + 16 * ((R >> 2) & 3) + 4 * ((R >> 4) & 1) + (R & 3)) : Epi::PERM ? ((R & ~31) + perm32(R & 31)) : R;
        voffA[i] = (unsigned)(R * pitch + C * 2); voffB[i] = (unsigned)(Rb * pitch + C * 2); }
    const size_t kstep = (size_t)(BK * 2);
    const size_t hstep = (size_t)HALF * pitch;
    const size_t tstep = 2 * hstep;
    const size_t hstepB = (int)Epi::PERM == 2 ? (size_t)8 * pitch : hstep;
    const unsigned ldsb = (unsigned)__builtin_amdgcn_readfirstlane((int)((unsigned)(uintptr_t)lds + (unsigned)wid * 1024u));
    const int aoff = lds_byte(wr * 64 + fr, fq * 8), boff = lds_byte(wc * 32 + fr, fq * 8);
#define PG8_SA(b, h) (((b) * 2 + (h)) * HTB)
#define PG8_SB(b, h) ((4 + (b) * 2 + (h)) * HTB)
#define PG8_STAGE(bufoff, gbase, voff) do { _Pragma("unroll") for (int _i = 0; _i < 2; ++_i) \
        glds16s((const void*)(gbase), (voff)[_i], ldsb + (unsigned)((bufoff) + _i * 8192)); } while (0)
#define PG8_LDA(dst, b, h) do { _Pragma("unroll") for (int m = 0; m < 4; ++m) _Pragma("unroll") for (int k = 0; k < 2; ++k) dst[m][k] = *(const PG8_LAS bf16x8*)(lds + PG8_SA(b, h) + aoff + m * 2048 + k * 1024); } while (0)
#define PG8_LDB(dst, b, h) do { _Pragma("unroll") for (int n = 0; n < 2; ++n) _Pragma("unroll") for (int k = 0; k < 2; ++k) dst[n][k] = *(const PG8_LAS bf16x8*)(lds + PG8_SB(b, h) + boff + n * 2048 + k * 1024); } while (0)
#define PG8_MMA(ai, bj, At, Bt) do { __builtin_amdgcn_s_setprio(1); _Pragma("unroll") for (int k = 0; k < 2; ++k) _Pragma("unroll") for (int m = 0; m < 4; ++m) _Pragma("unroll") for (int n = 0; n < 2; ++n) \
        acc[ai][bj][m][n] = __builtin_amdgcn_mfma_f32_16x16x32_bf16(Bt[n][k], At[m][k], acc[ai][bj][m][n], 0, 0, 0); __builtin_amdgcn_s_setprio(0); } while (0)
#define PG8_CAT(x0, x1) __builtin_shufflevector(__builtin_bit_cast(v4i_t, x0), __builtin_bit_cast(v4i_t, x1), 0, 1, 2, 3, 4, 5, 6, 7)
#define PG8_MMA8(ai, bj, At, Bt) do { __builtin_amdgcn_s_setprio(1); _Pragma("unroll") for (int m = 0; m < 4; ++m) _Pragma("unroll") for (int n = 0; n < 2; ++n) \
        acc[ai][bj][m][n] = __builtin_amdgcn_mfma_scale_f32_16x16x128_f8f6f4(PG8_CAT(Bt[n][0], Bt[n][1]), PG8_CAT(At[m][0], At[m][1]), acc[ai][bj][m][n], 0, 0, 0, F8_SCALE_W, 0, SCALE_A8); __builtin_amdgcn_s_setprio(0); } while (0)
#define PG8_MM(ai, bj, At, Bt) do { if constexpr (F8) PG8_MMA8(ai, bj, At, Bt); else PG8_MMA(ai, bj, At, Bt); } while (0)
#define PG8_WAIT_V(n) asm volatile("s_waitcnt vmcnt(" #n ")" ::: "memory")
#define PG8_WAIT_L(n) asm volatile("s_waitcnt lgkmcnt(" #n ")" ::: "memory")
#define PG8_BAR __builtin_amdgcn_s_barrier()
#define PG8_SCHED __builtin_amdgcn_sched_barrier(0)
    Unit cur, nxt; int ui = 0;
    if (!S.next(0, cur)) return;
    f32x4 acc[2][2][4][2];
#pragma unroll
    for (int a = 0; a < 2; ++a)
#pragma unroll
        for (int b = 0; b < 2; ++b)
#pragma unroll
            for (int m = 0; m < 4; ++m)
#pragma unroll
                for (int n = 0; n < 2; ++n) acc[a][b][m][n] = (f32x4){0.f, 0.f, 0.f, 0.f};
    bf16x8 At[4][2], B0[2][2], B1[2][2];
    const char* cA = (const char*)g.A + (size_t)cur.pm * tstep; const char* cB = (const char*)g.Bt + (size_t)cur.pn * tstep;
    S.a_ready(cur);
    if constexpr (SP2) {
        PG8_STAGE(PG8_SB(0, 0), cB, voffB); PG8_STAGE(PG8_SB(0, 1), cB + hstepB, voffB); PG8_STAGE(PG8_SA(0, 0), cA, voffA); PG8_STAGE(PG8_SA(0, 1), cA + hstep, voffA);
        if (wr == 1) PG8_BAR;
        PG8_WAIT_V(2); PG8_BAR;
        PG8_STAGE(PG8_SB(1, 0), cB + kstep, voffB); PG8_STAGE(PG8_SA(1, 0), cA + kstep, voffA); PG8_STAGE(PG8_SB(1, 1), cB + hstepB + kstep, voffB);
        PG8_WAIT_V(6); PG8_BAR;
    } else {
        PG8_STAGE(PG8_SB(0, 0), cB, voffB); PG8_STAGE(PG8_SA(0, 0), cA, voffA); PG8_STAGE(PG8_SB(0, 1), cB + hstepB, voffB); PG8_STAGE(PG8_SA(0, 1), cA + hstep, voffA);
        if (wr == 1) PG8_BAR;
        PG8_WAIT_V(4); PG8_BAR;
        PG8_STAGE(PG8_SB(1, 0), cB + kstep, voffB); PG8_STAGE(PG8_SA(1, 0), cA + kstep, voffA); PG8_STAGE(PG8_SB(1, 1), cB + hstepB + kstep, voffB);
        PG8_WAIT_V(6); PG8_BAR;
    }
    for (;;) {
        const bool has_next = S.next(ui + 1, nxt);
        const char* nA = has_next ? (const char*)g.A + (size_t)nxt.pm * tstep : cA; const char* nB = has_next ? (const char*)g.Bt + (size_t)nxt.pn * tstep : cB;
        if constexpr (MIXK > 0) {
            static_assert(SP2 && !F8, "mixed K needs the SP2 schedule");
            for (int t = 0; t < MIXK; t += 2) {
            const bool last = (t == nt - 2);
            const char* a1 = cA + PG8_KOFS(t + 1);
            const char* a2 = last ? nA : cA + PG8_KOFS(t + 2); const char* b2 = last ? nB : cB + PG8_KOFS(t + 2);
            const char* a3 = a2 + kstep; const char* b3 = b2 + kstep;
            if (last && has_next) S.a_ready(nxt);
            PG8_LDB(B0, 0, 0); PG8_LDB(B1, 0, 1); PG8_SCHED; PG8_LDA(At, 0, 0); PG8_STAGE(PG8_SA(1, 1), a1 + hstep, voffA);
            PG8_WAIT_V(8); PG8_WAIT_L(0); PG8_BAR; PG8_MMA8(0, 0, At, B0); PG8_MMA8(0, 1, At, B1); PG8_BAR; PG8_SCHED;
            PG8_LDA(At, 0, 1); PG8_STAGE(PG8_SB(0, 0), b2, voffB); PG8_STAGE(PG8_SB(0, 1), b2 + hstepB, voffB); PG8_STAGE(PG8_SA(0, 0), a2, voffA);
            PG8_WAIT_V(8); PG8_WAIT_L(0); PG8_BAR; PG8_MMA8(1, 0, At, B0); PG8_MMA8(1, 1, At, B1); PG8_BAR; PG8_SCHED;
            PG8_LDB(B0, 1, 0); PG8_LDB(B1, 1, 1); PG8_SCHED; PG8_LDA(At, 1, 0); PG8_STAGE(PG8_SA(0, 1), a2 + hstep, voffA);
            PG8_WAIT_V(8); PG8_WAIT_L(0); PG8_BAR; PG8_MMA8(0, 0, At, B0); PG8_MMA8(0, 1, At, B1); PG8_BAR; PG8_SCHED;
            PG8_LDA(At, 1, 1); PG8_STAGE(PG8_SB(1, 0), b3, voffB); PG8_STAGE(PG8_SB(1, 1), b3 + hstepB, voffB); PG8_STAGE(PG8_SA(1, 0), a3, voffA);
            PG8_WAIT_V(8); PG8_WAIT_L(0); PG8_BAR; PG8_MMA8(1, 0, At, B0); PG8_MMA8(1, 1, At, B1); PG8_BAR; PG8_SCHED;
            }
            for (int t = MIXK; t < nt; t += 2) {
            const bool last = (t == nt - 2);
            const char* a1 = cA + PG8_KOFS(t + 1);
            const char* a2 = last ? nA : cA + PG8_KOFS(t + 2); const char* b2 = last ? nB : cB + PG8_KOFS(t + 2);
            const char* a3 = a2 + kstep; const char* b3 = b2 + kstep;
            if (last && has_next) S.a_ready(nxt);
            PG8_LDB(B0, 0, 0); PG8_LDB(B1, 0, 1); PG8_SCHED; PG8_LDA(At, 0, 0); PG8_STAGE(PG8_SA(1, 1), a1 + hstep, voffA);
            PG8_WAIT_V(8); PG8_WAIT_L(0); PG8_BAR; PG8_MMA(0, 0, At, B0); PG8_MMA(0, 1, At, B1); PG8_BAR; PG8_SCHED;
            PG8_LDA(At, 0, 1); PG8_STAGE(PG8_SB(0, 0), b2, voffB); PG8_STAGE(PG8_SB(0, 1), b2 + hstepB, voffB); PG8_STAGE(PG8_SA(0, 0), a2, voffA);
            PG8_WAIT_V(8); PG8_WAIT_L(0); PG8_BAR; PG8_MMA(1, 0, At, B0); PG8_MMA(1, 1, At, B1); PG8_BAR; PG8_SCHED;
            PG8_LDB(B0, 1, 0); PG8_LDB(B1, 1, 1); PG8_SCHED; PG8_LDA(At, 1, 0); PG8_STAGE(PG8_SA(0, 1), a2 + hstep, voffA);
            PG8_WAIT_V(8); PG8_WAIT_L(0); PG8_BAR; PG8_MMA(0, 0, At, B0); PG8_MMA(0, 1, At, B1); PG8_BAR; PG8_SCHED;
            PG8_LDA(At, 1, 1); PG8_STAGE(PG8_SB(1, 0), b3, voffB); PG8_STAGE(PG8_SB(1, 1), b3 + hstepB, voffB); PG8_STAGE(PG8_SA(1, 0), a3, voffA);
            PG8_WAIT_V(8); PG8_WAIT_L(0); PG8_BAR; PG8_MMA(1, 0, At, B0); PG8_MMA(1, 1, At, B1); PG8_BAR; PG8_SCHED;
            }
        } else {
        for (int t = 0; t < nt; t += 2) {
            const bool last = (t == nt - 2);
            const char* a1 = cA + PG8_KOFS(t + 1);
            const char* a2 = last ? nA : cA + PG8_KOFS(t + 2); const char* b2 = last ? nB : cB + PG8_KOFS(t + 2);
            const char* a3 = a2 + kstep; const char* b3 = b2 + kstep;
            if (last && has_next) S.a_ready(nxt);
            if constexpr (SP2) {
            PG8_LDB(B0, 0, 0); PG8_LDB(B1, 0, 1); PG8_SCHED; PG8_LDA(At, 0, 0); PG8_STAGE(PG8_SA(1, 1), a1 + hstep, voffA);
            PG8_WAIT_V(8); PG8_WAIT_L(0); PG8_BAR; PG8_MM(0, 0, At, B0); PG8_MM(0, 1, At, B1); PG8_BAR; PG8_SCHED;
            PG8_LDA(At, 0, 1); PG8_STAGE(PG8_SB(0, 0), b2, voffB); PG8_STAGE(PG8_SB(0, 1), b2 + hstepB, voffB); PG8_STAGE(PG8_SA(0, 0), a2, voffA);
            PG8_WAIT_V(8); PG8_WAIT_L(0); PG8_BAR; PG8_MM(1, 0, At, B0); PG8_MM(1, 1, At, B1); PG8_BAR; PG8_SCHED;
            PG8_LDB(B0, 1, 0); PG8_LDB(B1, 1, 1); PG8_SCHED; PG8_LDA(At, 1, 0); PG8_STAGE(PG8_SA(0, 1), a2 + hstep, voffA);
            PG8_WAIT_V(8); PG8_WAIT_L(0); PG8_BAR; PG8_MM(0, 0, At, B0); PG8_MM(0, 1, At, B1); PG8_BAR; PG8_SCHED;
            PG8_LDA(At, 1, 1); PG8_STAGE(PG8_SB(1, 0), b3, voffB); PG8_STAGE(PG8_SB(1, 1), b3 + hstepB, voffB); PG8_STAGE(PG8_SA(1, 0), a3, voffA);
            PG8_WAIT_V(8); PG8_WAIT_L(0); PG8_BAR; PG8_MM(1, 0, At, B0); PG8_MM(1, 1, At, B1); PG8_BAR; PG8_SCHED;
            } else {
            PG8_LDB(B0, 0, 0); PG8_SCHED; PG8_LDA(At, 0, 0); PG8_STAGE(PG8_SA(1, 1), a1 + hstep, voffA);
            PG8_WAIT_L(8); PG8_BAR; PG8_WAIT_L(0); PG8_MM(0, 0, At, B0); PG8_BAR; PG8_SCHED;
            PG8_LDB(B1, 0, 1); PG8_STAGE(PG8_SB(0, 0), b2, voffB);
            PG8_BAR; PG8_WAIT_L(0); PG8_MM(0, 1, At, B1); PG8_BAR;
            PG8_LDA(At, 0, 1); PG8_STAGE(PG8_SA(0, 0), a2, voffA);
            PG8_BAR; PG8_WAIT_L(0); PG8_MM(1, 0, At, B0); PG8_BAR; PG8_SCHED;
            PG8_STAGE(PG8_SB(0, 1), b2 + hstepB, voffB);
            PG8_WAIT_V(6); PG8_BAR; PG8_MM(1, 1, At, B1); PG8_BAR;
            PG8_LDB(B0, 1, 0); PG8_SCHED; PG8_LDA(At, 1, 0); PG8_STAGE(PG8_SA(0, 1), a2 + hstep, voffA);
            PG8_WAIT_L(8); PG8_BAR; PG8_WAIT_L(0); PG8_MM(0, 0, At, B0); PG8_BAR; PG8_SCHED;
            PG8_LDB(B1, 1, 1); PG8_STAGE(PG8_SB(1, 0), b3, voffB);
            PG8_BAR; PG8_WAIT_L(0); PG8_MM(0, 1, At, B1); PG8_BAR;
            PG8_LDA(At, 1, 1); PG8_STAGE(PG8_SA(1, 0), a3, voffA);
            PG8_BAR; PG8_WAIT_L(0); PG8_MM(1, 0, At, B0); PG8_BAR; PG8_SCHED;
            PG8_STAGE(PG8_SB(1, 1), b3 + hstepB, voffB);
            PG8_WAIT_V(6); PG8_BAR; PG8_MM(1, 1, At, B1); PG8_BAR;
            }
        }
        }
        if constexpr (ALIGN_EPI) { if (wr == 0) PG8_BAR; }
        { const int le = hw_lane();
          if constexpr (!Epi::AFTER_DRAIN) { E(acc, cur, wr, wc, le & 15, le >> 4); S.done(cur); }
          else { if (has_next) { E(acc, cur, wr, wc, le & 15, le >> 4); S.done(cur); } } }
        if (!has_next) break;
#pragma unroll
        for (int a = 0; a < 2; ++a)
#pragma unroll
            for (int b = 0; b < 2; ++b)
#pragma unroll
                for (int m = 0; m < 4; ++m)
#pragma unroll
                    for (int n = 0; n < 2; ++n) acc[a][b][m][n] = (f32x4){0.f, 0.f, 0.f, 0.f};
        cur = nxt; cA = nA; cB = nB; ++ui;
        if constexpr (ALIGN_EPI) { if (wr == 1) PG8_BAR; }
    }
    PG8_WAIT_V(0);
    if constexpr (!ALIGN_EPI) { if (wr == 0) PG8_BAR; }
    PG8_BAR;
    if constexpr (Epi::AFTER_DRAIN) { const int le = hw_lane(); E.fused(acc, cur, wr, wc, le & 15, le >> 4, lds, wid, le); S.done(cur); }
#undef PG8_SA
#undef PG8_SB
#undef PG8_STAGE
#undef PG8_LDA
#undef PG8_LDB
#undef PG8_MMA
#undef PG8_MMA8
#undef PG8_MM
#undef PG8_CAT
#undef PG8_KOFS
#undef PG8_WAIT_V
#undef PG8_WAIT_L
#undef PG8_BAR
#undef PG8_SCHED
}
}

constexpr int NWAVES = 8;
constexpr int N_LAUNCHES = MK_N_LAUNCHES;
constexpr int N_PHASES = 6;

constexpr size_t MiB = 1u << 20;
constexpr size_t WS_CTL = 0, CTL_ZERO_BYTES = 64 * 1024;
constexpr size_t WS_WIN = 2 * MiB;
constexpr size_t WS_WOUT = 130 * MiB;
constexpr size_t WS_U = 162 * MiB;
constexpr size_t WS_PROJ = 226 * MiB;
constexpr size_t WS_MIX = 482 * MiB;
constexpr size_t WS_PART = 546 * MiB;
constexpr size_t WS_LSE = 674 * MiB;
constexpr size_t WS_KSUM = 676 * MiB;
constexpr size_t WS_LIST = 677 * MiB;
constexpr size_t WS_CNT = 685 * MiB;
constexpr size_t WS_ROWSS = 686 * MiB;
constexpr size_t WS_W8 = 688 * MiB;
constexpr size_t WS_U8 = 720 * MiB;
constexpr size_t WS_TH = 752 * MiB;
constexpr size_t WS_BZT = 754 * MiB;
constexpr size_t WS_KVZ8 = 760 * MiB;
constexpr size_t WS_END = 809 * MiB;
constexpr int CW_BAR = 4096;
constexpr int CW_ITEM = 64;
constexpr int CW_PANEL = 8192;
constexpr int CW_TMO = 2;

constexpr int RING_BYTES = 131072;
constexpr int LDSCTL_OFF = RING_BYTES, MISC_OFF = LDSCTL_OFF + 320;
constexpr int ATT_LUT_OFF = RING_BYTES + 1024;
constexpr int ATT_MISC_OFF = ATT_LUT_OFF + 3072;
constexpr int LDS_BYTES = 147456;

typedef GAS unsigned gu32;
#define RLX_AGENT __ATOMIC_RELAXED, __HIP_MEMORY_SCOPE_AGENT
#define LDS_WAIT() asm volatile("s_waitcnt lgkmcnt(0)" ::: "memory")
#define VM_WAIT() asm volatile("s_waitcnt vmcnt(0)" ::: "memory")

#define XB_TMO      128
#define XB_XCNT(j)  (256  + 64 * (j))
#define XB_XSUB(j)  (1280 + 64 * (j))
#define XB_XGEN(j)  (2304 + 64 * (j))
#define XB_TOP      3328
#define XB_TOPGEN   3392
#define XCD_BAR_WORDS 3456
#define XB_SPIN_CAP (1u << 20)
__device__ __forceinline__ unsigned xb_ld(unsigned* p)              { return __hip_atomic_load(p, __ATOMIC_RELAXED, __HIP_MEMORY_SCOPE_AGENT); }
__device__ __forceinline__ unsigned xb_add(unsigned* p, unsigned v) { return __hip_atomic_fetch_add(p, v, __ATOMIC_RELAXED, __HIP_MEMORY_SCOPE_AGENT); }
__device__ __forceinline__ unsigned xb_xcc_id() { return (unsigned)__builtin_amdgcn_s_getreg((3 << 11) | 20) & 0xFu; }
#define XB_SPIN(cond, bar) do { unsigned _sp = 0; while (cond) { __builtin_amdgcn_s_sleep(1); \
    if ((++_sp & 255u) == 0u) { if (xb_ld(&(bar)[XB_TMO])) break; if (_sp > XB_SPIN_CAP) { atomicAdd(&(bar)[XB_TMO], 1u); break; } } } } while (0)
struct XcdBarrier { unsigned* bar; unsigned x; volatile LAS unsigned* st; };
__device__ __forceinline__ XcdBarrier xcd_barrier_post(unsigned* bar, volatile LAS unsigned* st) {
    XcdBarrier b; b.bar = bar; b.x = xb_xcc_id(); b.st = st;
    if (threadIdx.x == 0) (void)xb_add(&bar[XB_XCNT(b.x)], 1u);
    return b;
}
__device__ __forceinline__ void xcd_barrier_complete(unsigned* bar, unsigned x, unsigned& nloc, unsigned& nx) {
    const unsigned G = gridDim.x * gridDim.y * gridDim.z;
    unsigned sum, cnt, mine, sp = 0u;
    for (;;) {
        sum = 0u; cnt = 0u; mine = 0u;
#pragma unroll
        for (unsigned j = 0; j < 16; ++j) { const unsigned c = xb_ld(&bar[XB_XCNT(j)]); sum += c; cnt += (c > 0u) ? 1u : 0u; mine = (j == x) ? c : mine; }
        if (sum == G) break;
        __builtin_amdgcn_s_sleep(1);
        if ((++sp & 255u) == 0u) { if (xb_ld(&bar[XB_TMO])) break; if (sp > XB_SPIN_CAP) { atomicAdd(&bar[XB_TMO], 1u); break; } }
    }
    nloc = mine > 0u ? mine : 1u; nx = cnt > 0u ? cnt : 1u;
}
__device__ __forceinline__ void xcd_barrier(const XcdBarrier& b) {
    asm volatile("s_waitcnt vmcnt(0)" ::: "memory");
    __syncthreads();
    if (threadIdx.x == 0) {
        unsigned* bar = b.bar;
        __builtin_amdgcn_s_waitcnt(0);
        unsigned nloc = b.st[0], nx = b.st[1];
        if (nloc == 0u) { xcd_barrier_complete(bar, b.x, nloc, nx); b.st[0] = nloc; b.st[1] = nx; }
        const unsigned old = xb_add(&bar[XB_XSUB(b.x)], 1u);
        const unsigned gen = old / nloc;
        if (old + 1u == (gen + 1u) * nloc) {
            __builtin_amdgcn_fence(__ATOMIC_RELEASE, "agent");
            asm volatile("s_waitcnt vmcnt(0)" ::: "memory");
            const unsigned og = xb_add(&bar[XB_TOP], 1u);
            asm volatile("buffer_inv sc1" ::: "memory");
            const unsigned tg = og / nx;
            if (og + 1u == (tg + 1u) * nx) xb_add(&bar[XB_TOPGEN], 1u);
            else XB_SPIN(xb_ld(&bar[XB_TOPGEN]) == tg, bar);
            asm volatile("s_waitcnt vmcnt(0)" ::: "memory");
        } else {
            asm volatile("buffer_inv sc1" ::: "memory");
            XB_SPIN(xb_ld(&bar[XB_TOPGEN]) == gen, bar);
            asm volatile("s_waitcnt vmcnt(0)" ::: "memory");
        }
    }
    __syncthreads();
}

struct Frame {
    LAS unsigned char* lds;
    volatile LAS unsigned* MISC;
    unsigned* ctl;
    int wave, vcu, G;
    const float *x, *ng, *w_in, *conv_w, *w_out, *rel_bias, *fg; float* out;
    bf16_t *WinT, *WoutT, *U, *PROJ, *MIX, *PART; unsigned char *W8, *U8, *KVZ8; float *TH, *BZT; float *LSE, *KSUM, *ROWSS; unsigned short* LIST; int* CNT;
};

__device__ __forceinline__ float wave_sum(float v) {
#pragma unroll
    for (int o = 1; o < 64; o <<= 1) v += __shfl_xor(v, o);
    return v;
}

__device__ __forceinline__ int hperm(int d) { return 32 * (d >> 5) + 16 * ((d >> 2) & 1) + 4 * ((d >> 3) & 3) + (d & 3); }
__device__ __forceinline__ void p0_tile_load(f32x4 (&v)[8], const float* W, int N, int kb, int nb, int wave, int lane) {
    const float* src = W + (size_t)(64 * kb + 8 * wave) * N + 256 * nb + 4 * lane;
#pragma unroll
    for (int i = 0; i < 8; ++i) v[i] = __builtin_nontemporal_load((const f32x4*)(src + (size_t)i * N));
}
template <bool KPERM, bool CPERM> __device__ __forceinline__ void p0_tile_store(const f32x4 (&v)[8], bf16_t* WT, int kb, int nb, LAS unsigned* T, int tid, int wave, int lane) {
#pragma unroll
    for (int ii = 0; ii < 4; ++ii) { const int kp = 4 * wave + ii; u32x4 d;
        d.x = cvtpk(v[2 * ii][0], v[2 * ii + 1][0]); d.y = cvtpk(v[2 * ii][1], v[2 * ii + 1][1]); d.z = cvtpk(v[2 * ii][2], v[2 * ii + 1][2]); d.w = cvtpk(v[2 * ii][3], v[2 * ii + 1][3]);
        *(LAS u32x4*)(T + kp * 256 + ((4 * lane) ^ (wave << 2))) = d; }
    LDS_WAIT(); __syncthreads();
#pragma unroll
    for (int i = 0; i < 4; ++i) { const int idx = tid + 512 * i, n = idx >> 3, c = idx & 7; u32x4 o;
        const LAS unsigned* tp = T + (4 * c) * 256 + (n ^ (c << 2));
        o.x = tp[0]; o.y = tp[256]; o.z = tp[512]; o.w = tp[768];
        int R = 256 * nb + n; if (CPERM) { const int q = R - 8192, kind = q >> 11, chn = q & 2047, cl = chn & 63; R = 8192 + 256 * (chn >> 6) + 128 * (kind >> 1) + 32 * (cl >> 4) + 8 * ((cl >> 2) & 3) + 4 * (kind & 1) + (cl & 3); }
        bf16_t* rowp = WT + (size_t)R * 4096;
        if (KPERM) { const int kp = 128 * (kb >> 1) + 16 * (2 * (kb & 1) + (c >> 2)) + 4 * (c & 3); *(u32x2*)(rowp + kp) = (u32x2){o.x, o.y}; *(u32x2*)(rowp + kp + 64) = (u32x2){o.z, o.w}; }
        else *(u32x4*)(rowp + 64 * kb + 8 * c) = o; }
    LDS_WAIT(); __syncthreads();
}
template <bool WOUT> __device__ __forceinline__ void p0_tile_store_f8(const f32x4 (&v)[8], unsigned char* W8, int kb, int nb8, LAS unsigned* T, int tid, int wave, int lane) {
#pragma unroll
    for (int q2 = 0; q2 < 2; ++q2) { const int kq = 2 * wave + q2; u32x4 d;
#pragma unroll
        for (int c = 0; c < 4; ++c) {
#define W8C(x) __builtin_amdgcn_fmed3f((x) * 128.f, -448.f, 448.f)
            int w32 = __builtin_amdgcn_cvt_pk_fp8_f32(W8C(v[4 * q2][c]), W8C(v[4 * q2 + 1][c]), 0, false); w32 = __builtin_amdgcn_cvt_pk_fp8_f32(W8C(v[4 * q2 + 2][c]), W8C(v[4 * q2 + 3][c]), w32, true); d[c] = (unsigned)w32;
#undef W8C
        }
        *(LAS u32x4*)(T + kq * 256 + ((4 * lane) ^ (((kq >> 2) & 3) << 3))) = d; }
    LDS_WAIT(); __syncthreads();
#pragma unroll
    for (int i = 0; i < 2; ++i) { const int idx = tid + 512 * i, n = idx >> 2, c = idx & 3; u32x4 o;
        const LAS unsigned* tp = T + (4 * c) * 256 + (n ^ (c << 3));
        o.x = tp[0]; o.y = tp[256]; o.z = tp[512]; o.w = tp[768];
        if (WOUT) {
            unsigned char* rowp = W8 + (size_t)(256 * nb8 + n) * 8192 + 128 * (kb >> 1) + 32 * (2 * (kb & 1) + (c >> 1)) + 8 * (c & 1);
            *(u32x2*)(rowp) = (u32x2){o.x, o.z}; *(u32x2*)(rowp + 16) = (u32x2){o.y, o.w};
        } else {
        int R = 256 * nb8 + n; if (R >= COL_ZA) R = (R & ~127) + hperm(R & 127);
        *(u32x4*)(W8 + (size_t)R * 4096 + 64 * kb + 16 * c) = o; } }
    LDS_WAIT(); __syncthreads();
}
__device__ __forceinline__ void p0_decode(int it, const float* w_in, const float* w_out, bf16_t* WinT, bf16_t* WoutT, const float*& W, int& N, bf16_t*& WT, int& kb, int& nb) {
    if (it < 4096) { W = w_in; N = PW; WT = WinT; nb = it & 63; kb = it >> 6; }
    else { const int r = it - 4096; W = w_out; N = DM; WT = WoutT; nb = r & 15; kb = r >> 4; }
}
__device__ __forceinline__ void p0_tile_out(const f32x4 (&v)[8], Frame& F, bf16_t* WT, int kb, int nb, LAS unsigned* T, int tid, int lane) {
    if (WT == F.WinT && nb < 32) p0_tile_store_f8<false>(v, F.W8, kb, nb, T, tid, F.wave, lane);
    else if (WT == F.WoutT && kb < 32) p0_tile_store_f8<true>(v, (unsigned char*)F.WoutT, kb, nb, T, tid, F.wave, lane);
    else if (WT == F.WinT) p0_tile_store<false, true>(v, WT, kb, nb, T, tid, F.wave, lane);
    else p0_tile_store<false, false>(v, WT, kb, nb, T, tid, F.wave, lane);
}
__device__ __forceinline__ void p0_prologue(Frame& F) {
    const int lane = hw_lane(), tid = F.wave * 64 + lane;
    { const int gt = F.vcu * 512 + tid, NT = F.G * 512; for (int i = gt; i < NB * 2048 / 4; i += NT) ((f32x4*)F.KSUM)[i] = (f32x4){0.f, 0.f, 0.f, 0.f}; }
    {
        LAS unsigned* T = (LAS unsigned*)F.lds;
        constexpr int NIT = 4096;
        f32x4 va[8], vb[8]; const float* W; int N, kb, nb; bf16_t* WT;
        int it = F.vcu;
        if (it < NIT) { p0_decode(it, F.w_in, F.w_out, F.WinT, F.WoutT, W, N, WT, kb, nb); p0_tile_load(va, W, N, kb, nb, F.wave, lane); }
        while (it < NIT) {
            const float* W2; int N2, kb2, nb2; bf16_t* WT2; const int it2 = it + F.G;
            if (it2 < NIT) { p0_decode(it2, F.w_in, F.w_out, F.WinT, F.WoutT, W2, N2, WT2, kb2, nb2); p0_tile_load(vb, W2, N2, kb2, nb2, F.wave, lane); }
            p0_tile_out(va, F, WT, kb, nb, T, tid, lane);
            it = it2; if (it >= NIT) break;
            const int it3 = it + F.G;
            if (it3 < NIT) { p0_decode(it3, F.w_in, F.w_out, F.WinT, F.WoutT, W, N, WT, kb, nb); p0_tile_load(va, W, N, kb, nb, F.wave, lane); }
            p0_tile_out(vb, F, WT2, kb2, nb2, T, tid, lane);
            it = it3;
        }
    }
    {
        const int gw = F.vcu * NWAVES + F.wave, NGW = F.G * NWAVES;
        for (int row = gw; row < SEQ; row += NGW) {
            const f32x4* xr = (const f32x4*)(F.x + (size_t)row * DM) + lane; f32x4 v[16]; float ss = 0.f;
#pragma unroll
            for (int j = 0; j < 16; ++j) { v[j] = __builtin_nontemporal_load(xr + 64 * j); ss += (v[j][0] * v[j][0] + v[j][1] * v[j][1]) + (v[j][2] * v[j][2] + v[j][3] * v[j][3]); }
            const float rstd = 1.0f / sqrtf(wave_sum(ss) * (1.f / DM) + EPS);
            const f32x4* gr = (const f32x4*)F.ng + lane; u32x2* o8 = (u32x2*)(F.U + (size_t)row * DM) + lane; unsigned* o4 = (unsigned*)(F.U8 + (size_t)row * DM) + lane;
#pragma unroll
            for (int j = 0; j < 16; ++j) { const f32x4 g = gr[64 * j]; const float u0 = v[j][0] * rstd * g[0], u1 = v[j][1] * rstd * g[1], u2 = v[j][2] * rstd * g[2], u3 = v[j][3] * rstd * g[3];
                u32x2 w; w.x = cvtpk(u0, u1); w.y = cvtpk(u2, u3); o8[64 * j] = w;

#define U8C(x) __builtin_amdgcn_fmed3f((x) * 4.f, -448.f, 448.f)
                int w8 = __builtin_amdgcn_cvt_pk_fp8_f32(U8C(u0), U8C(u1), 0, false); w8 = __builtin_amdgcn_cvt_pk_fp8_f32(U8C(u2), U8C(u3), w8, true); o4[64 * j] = (unsigned)w8; }
#undef U8C
        }
    }
}

#define TOP_BETTER(v, i, w, k) ((v) > (w) || ((v) == (w) && (i) < (k)))
#define TOP_INSERT(v, i) do { if (TOP_BETTER(v, i, v0, i0)) { v2 = v1; i2 = i1; v1 = v0; i1 = i0; v0 = (v); i0 = (i); } \
    else if (TOP_BETTER(v, i, v1, i1)) { v2 = v1; i2 = i1; v1 = (v); i1 = (i); } else if (TOP_BETTER(v, i, v2, i2)) { v2 = (v); i2 = (i); } } while (0)
__device__ __forceinline__ void p2_route(Frame& F) {
    const int lane = hw_lane(), tid = F.wave * 64 + lane;
    LAS int* lcnt = (LAS int*)F.lds;
    const int r32 = lane & 31, hi = lane >> 5;
    for (int u = F.vcu; u < NH * (NB - 1); u += F.G) {
        const int h = u & 15, qb = 1 + (u >> 4);
        if (tid < 32) lcnt[tid] = 0;
        __syncthreads();
        bf16x8 khi[8], klo[8], q[8];
        const float* kp = F.KSUM + (size_t)r32 * 2048 + h * HD + 8 * hi;
        const int ql = 32 * F.wave + r32, s = qb * BLK + ql;
        const bf16_t* qp = F.PROJ + ((size_t)h * HSQ + s) * HD + 8 * hi;
#pragma unroll
        for (int st = 0; st < 8; ++st) {
            const f32x4 a = *(const f32x4*)(kp + 16 * st), b = *(const f32x4*)(kp + 16 * st + 4);
            float f[8] = {a[0], a[1], a[2], a[3], b[0], b[1], b[2], b[3]}; u32x4 wh, wl; unsigned hh[4], ll[4];
#pragma unroll
            for (int e = 0; e < 4; ++e) { const float x0 = f[2 * e] * (1.f / 256.f), x1 = f[2 * e + 1] * (1.f / 256.f); const unsigned w = cvtpk(x0, x1); hh[e] = w; ll[e] = cvtpk(x0 - bf_lo(w), x1 - bf_hi(w)); }
            wh = (u32x4){hh[0], hh[1], hh[2], hh[3]}; wl = (u32x4){ll[0], ll[1], ll[2], ll[3]};
            khi[st] = __builtin_bit_cast(bf16x8, wh); klo[st] = __builtin_bit_cast(bf16x8, wl);
            q[st] = *(const bf16x8*)(qp + 16 * st);
        }
        f32x16 acc; for (int r = 0; r < 16; ++r) acc[r] = 0.f;
#pragma unroll
        for (int st = 0; st < 8; ++st) { acc = __builtin_amdgcn_mfma_f32_32x32x16_bf16(khi[st], q[st], acc, 0, 0, 0); acc = __builtin_amdgcn_mfma_f32_32x32x16_bf16(klo[st], q[st], acc, 0, 0, 0); }
        float v0 = -INFINITY, v1 = -INFINITY, v2 = -INFINITY; int i0 = 64, i1 = 65, i2 = 66;
#pragma unroll
        for (int r = 0; r < 16; ++r) { const int blk = crow(r, hi); const float v = (blk < qb) ? acc[r] : -INFINITY; TOP_INSERT(v, blk); }
        { const float p0 = __shfl_xor(v0, 32), p1 = __shfl_xor(v1, 32), p2 = __shfl_xor(v2, 32); const int j0 = __shfl_xor(i0, 32), j1 = __shfl_xor(i1, 32), j2 = __shfl_xor(i2, 32);
          TOP_INSERT(p0, j0); TOP_INSERT(p1, j1); TOP_INSERT(p2, j2); }
        const int nv = qb < 3 ? qb : 3;
        if (hi == 0) {
            const int sel[3] = {i0, i1, i2};
#pragma unroll
            for (int r = 0; r < 3; ++r) if (r < nv) { const int n = sel[r]; const int pos = __hip_atomic_fetch_add(lcnt + n, 1, __ATOMIC_RELAXED, __HIP_MEMORY_SCOPE_WORKGROUP);
                F.LIST[(((size_t)h * NB + n) * NB + qb) * BLK + pos] = (unsigned short)(s | (r << 13)); }
        }
        LDS_WAIT(); __syncthreads();
        if (tid < qb) F.CNT[((size_t)h * NB + tid) * NB + qb] = lcnt[tid];
        __syncthreads();
    }
}

template <bool GENERAL>
__device__ __forceinline__ void att_tile(const LAS unsigned char* Kl, const LAS unsigned char* Vl, const LAS float* lutp, float c31, int nkt,
                                         const bf16x8 (&qr)[8], int r32_, int hi_, int lane_, float& m_out, float& l_out, f32x16 (&o)[4]) {
    const int lane = hw_lane(), r32 = lane & 31, hi = lane >> 5;
    (void)r32_; (void)hi_; (void)lane_;
    float m = 0.f, l = 0.f;
#pragma unroll
    for (int d0 = 0; d0 < 4; ++d0) for (int r = 0; r < 16; ++r) o[d0][r] = 0.f;
    const int X = (r32 & 15) << 4;
    const int i16 = lane & 15, qq = i16 >> 2, pp = i16 & 3, blk = (lane >> 4) & 1;
    int vb[4];
#pragma unroll
    for (int d0 = 0; d0 < 4; ++d0) vb[d0] = 256 * (4 * hi + qq) + 16 * (4 * (d0 ^ qq) + 2 * blk + (pp >> 1)) + 8 * (pp & 1);
    for (int kt = 0; kt < nkt; ++kt) {
        f32x16 p0, p1;
#pragma unroll
        for (int r = 0; r < 16; ++r) { p0[r] = 0.f; p1[r] = 0.f; }
        const LAS unsigned char* kr = Kl + 256 * (64 * kt + r32);
#pragma unroll
        for (int st = 0; st < 8; ++st) {
            const int cb = (32 * st + 16 * hi) ^ X;
            const bf16x8 a0 = *(const LAS bf16x8*)(kr + cb), a1 = *(const LAS bf16x8*)(kr + 32 * 256 + cb);
            p0 = __builtin_amdgcn_mfma_f32_32x32x16_bf16(a0, qr[st], p0, 0, 0, 0);
            p1 = __builtin_amdgcn_mfma_f32_32x32x16_bf16(a1, qr[st], p1, 0, 0, 0);
        }
        if (GENERAL) {
            const LAS float* lp = lutp - 64 * kt;
#pragma unroll
            for (int r = 0; r < 16; ++r) { const int kk = (r & 3) + 8 * (r >> 2); p0[r] = fmaf(p0[r], QK_C, lp[-kk]) - m; p1[r] = fmaf(p1[r], QK_C, lp[-kk - 32]) - m; }
        } else {
            const float bm = c31 - m;
#pragma unroll
            for (int r = 0; r < 16; ++r) { p0[r] = fmaf(p0[r], QK_C, bm); p1[r] = fmaf(p1[r], QK_C, bm); }
        }
        float pa = __builtin_fmaxf(__builtin_fmaxf(p0[0], p0[1]), p1[0]), pb_ = __builtin_fmaxf(__builtin_fmaxf(p0[2], p0[3]), p1[1]); pa = __builtin_fmaxf(__builtin_fmaxf(pa, p1[2]), p1[3]);
#pragma unroll
        for (int r = 4; r < 16; r += 4) { pa = __builtin_fmaxf(__builtin_fmaxf(pa, p0[r]), p0[r + 1]); pb_ = __builtin_fmaxf(__builtin_fmaxf(pb_, p0[r + 2]), p0[r + 3]);
            pa = __builtin_fmaxf(__builtin_fmaxf(pa, p1[r]), p1[r + 1]); pb_ = __builtin_fmaxf(__builtin_fmaxf(pb_, p1[r + 2]), p1[r + 3]); }
        float pmax = __builtin_fmaxf(pa, pb_);
        { auto rr = __builtin_amdgcn_permlane32_swap(__float_as_uint(pmax), __float_as_uint(pmax), false, false); pmax = fmaxf(__uint_as_float(rr[0]), __uint_as_float(rr[1])); }
        if (kt == 0 || __any(pmax > 8.f)) {
            const float dl = kt == 0 ? pmax : fmaxf(pmax, 0.f);
            m += dl;
#pragma unroll
            for (int r = 0; r < 16; ++r) { p0[r] -= dl; p1[r] -= dl; }
            if (kt > 0) {
                const float alpha = __builtin_amdgcn_exp2f(-dl);
                l *= alpha;
#pragma unroll
                for (int d0 = 0; d0 < 4; ++d0) for (int r = 0; r < 16; ++r) o[d0][r] *= alpha;
            }
        }
        float ps = 0.f;
#pragma unroll
        for (int r = 0; r < 16; ++r) { p0[r] = __builtin_amdgcn_exp2f(p0[r]); p1[r] = __builtin_amdgcn_exp2f(p1[r]); ps += p0[r] + p1[r]; }
        l += ps;
        bf16x8 pb[4];
#pragma unroll
        for (int s2 = 0; s2 < 2; ++s2) {
            u32x4 w0 = {cvtpk(p0[8 * s2], p0[8 * s2 + 1]), cvtpk(p0[8 * s2 + 2], p0[8 * s2 + 3]), cvtpk(p0[8 * s2 + 4], p0[8 * s2 + 5]), cvtpk(p0[8 * s2 + 6], p0[8 * s2 + 7])};
            u32x4 w1 = {cvtpk(p1[8 * s2], p1[8 * s2 + 1]), cvtpk(p1[8 * s2 + 2], p1[8 * s2 + 3]), cvtpk(p1[8 * s2 + 4], p1[8 * s2 + 5]), cvtpk(p1[8 * s2 + 6], p1[8 * s2 + 7])};
            pb[s2] = __builtin_bit_cast(bf16x8, w0); pb[2 + s2] = __builtin_bit_cast(bf16x8, w1);
        }
        const LAS unsigned char* vt = Vl + 256 * 64 * kt;
#pragma unroll
        for (int d0 = 0; d0 < 4; ++d0)
#pragma unroll
            for (int ks = 0; ks < 4; ++ks) {
                const LAS unsigned char* vp = vt + vb[d0] + 256 * 16 * ks;
                const s16x4 lo4 = __builtin_bit_cast(s16x4, __builtin_amdgcn_ds_read_tr16_b64_v4i16((LAS s16x4*)(vp)));
                const s16x4 hi4 = __builtin_bit_cast(s16x4, __builtin_amdgcn_ds_read_tr16_b64_v4i16((LAS s16x4*)(vp + 256 * 8)));
                const bf16x8 va = __builtin_shufflevector(lo4, hi4, 0, 1, 2, 3, 4, 5, 6, 7);
                o[d0] = __builtin_amdgcn_mfma_f32_32x32x16_bf16(va, pb[ks], o[d0], 0, 0, 0);
            }
    }
    m_out = m; l_out = l;
}

__device__ __forceinline__ void att_stage_kv(Frame& F, int h, int j, LAS unsigned char* Kl, LAS unsigned char* Vl, LAS float* lut) {
    const int tid = F.wave * 64 + hw_lane();
    const unsigned char* kg = F.KVZ8 + ((size_t)h * HSQ + j * BLK) * HD; const unsigned char* vg = kg + (size_t)NH * HSQ * HD;
    u32x4 kv[4], vv[4];
#pragma unroll
    for (int i = 0; i < 4; ++i) { const int p = tid + 512 * i, row = p >> 3, c8 = p & 7; kv[i] = *(const u32x4*)(kg + row * 128 + 16 * c8); vv[i] = *(const u32x4*)(vg + row * 128 + 16 * c8); }
    for (int i = tid; i < 768; i += 512) {
        const int dist = i - 255; float v;
        if (dist < 0) v = -INFINITY;
        else { int b; if (dist < 16) b = dist; else { b = 16 + (int)(logf((float)dist * (1.f / 16.f)) / logf(8.f) * 16.f); b = b > 31 ? 31 : b; }
               v = F.rel_bias[b * NH + h] * LOG2E; }
        lut[i] = v;
    }
#define F8TOBF(x, lo, hi_) do { const f32x2_t a_ = __builtin_amdgcn_cvt_pk_f32_fp8((int)(x), false), b_ = __builtin_amdgcn_cvt_pk_f32_fp8((int)(x), true); lo = cvtpk(a_[0], a_[1]); hi_ = cvtpk(b_[0], b_[1]); } while (0)
#pragma unroll
    for (int i = 0; i < 4; ++i) { const int p = tid + 512 * i, row = p >> 3, c8 = p & 7;
        u32x4 k0, k1, v0, v1;
        F8TOBF(kv[i].x, k0.x, k0.y); F8TOBF(kv[i].y, k0.z, k0.w); F8TOBF(kv[i].z, k1.x, k1.y); F8TOBF(kv[i].w, k1.z, k1.w);
        F8TOBF(vv[i].x, v0.x, v0.y); F8TOBF(vv[i].y, v0.z, v0.w); F8TOBF(vv[i].z, v1.x, v1.y); F8TOBF(vv[i].w, v1.z, v1.w);
        *(LAS u32x4*)(Kl + 256 * row + ((16 * (2 * c8)) ^ ((row & 15) << 4))) = k0; *(LAS u32x4*)(Kl + 256 * row + ((16 * (2 * c8 + 1)) ^ ((row & 15) << 4))) = k1;
        *(LAS u32x4*)(Vl + 256 * row + 16 * ((2 * c8) ^ ((row & 3) << 2))) = v0; *(LAS u32x4*)(Vl + 256 * row + 16 * ((2 * c8 + 1) ^ ((row & 3) << 2))) = v1; }
#undef F8TOBF
}

constexpr int TG = 16;
constexpr int ATT_TAB_OFF = RING_BYTES + 4608;
constexpr int ATT_NT_OFF = ATT_TAB_OFF + 2304;
struct TileMeta { int s, slot, dbase, valid; };
__device__ __forceinline__ void p3_fetch(Frame& F, int h, int j, int t, int n, const LAS int* pre, int r32, int hi, TileMeta& mt, bf16x8 (&q)[8]) {
    const int e0 = 32 * t + r32; mt.valid = e0 < n ? 1 : 0; const int e = mt.valid ? e0 : n - 1;
    int lo = 0, hh = 32;
#pragma unroll
    for (int it = 0; it < 5; ++it) { const int mid = (lo + hh) >> 1; if (pre[mid] <= e) lo = mid; else hh = mid; }
    const int qb = lo;
    const unsigned ent = F.LIST[(((size_t)h * NB + j) * NB + qb) * BLK + (e - pre[qb])];
    mt.s = ent & 8191; mt.slot = ent >> 13; mt.dbase = mt.s - j * BLK;
    const bf16_t* qp = F.PROJ + ((size_t)h * HSQ + mt.s) * HD + 8 * hi;
#pragma unroll
    for (int st = 0; st < 8; ++st) q[st] = *(const bf16x8*)(qp + 16 * st);
}
__device__ __forceinline__ void p3_compute_store(Frame& F, int h, const LAS unsigned char* Kl, const LAS unsigned char* Vl, const LAS float* lut, float c31,
                                                 const TileMeta& mt, const bf16x8 (&qr)[8], int r32, int hi, int lane) {
    f32x16 o[4]; float m, l;
    const int dbc = mt.dbase < 511 ? mt.dbase : 511;
    const bool general = !__all(mt.dbase >= 368);
    if (general) att_tile<true>(Kl, Vl, lut + (dbc + 255 - 4 * hi), c31, 4, qr, r32, hi, lane, m, l, o);
    else att_tile<false>(Kl, Vl, lut, c31, 4, qr, r32, hi, lane, m, l, o);
    { auto rr = __builtin_amdgcn_permlane32_swap(__float_as_uint(l), __float_as_uint(l), false, false); l = __uint_as_float(rr[0]) + __uint_as_float(rr[1]); }
    const float inv = 1.0f / l;
    if (mt.valid) {
        unsigned char* op = (unsigned char*)F.PART + (((size_t)h * HSQ + mt.s) * 4 + mt.slot) * HD + 16 * hi;
        const float sc = inv * (16.f / 8.f);
#pragma unroll
        for (int d0 = 0; d0 < 4; ++d0) { u32x4 w;
#pragma unroll
            for (int q4 = 0; q4 < 4; ++q4) { int x = __builtin_amdgcn_cvt_pk_fp8_f32(__builtin_amdgcn_fmed3f(o[d0][4 * q4] * sc, -448.f, 448.f), __builtin_amdgcn_fmed3f(o[d0][4 * q4 + 1] * sc, -448.f, 448.f), 0, false);
                x = __builtin_amdgcn_cvt_pk_fp8_f32(__builtin_amdgcn_fmed3f(o[d0][4 * q4 + 2] * sc, -448.f, 448.f), __builtin_amdgcn_fmed3f(o[d0][4 * q4 + 3] * sc, -448.f, 448.f), x, true); w[q4] = (unsigned)x; }
            *(u32x4*)(op + 32 * d0) = w; }
        if (hi == 0) F.LSE[((size_t)h * SEQ + mt.s) * 4 + mt.slot] = m + __log2f(l);
    }
}
__device__ __forceinline__ void p3a_selected(Frame& F, int cw_item) {
    const int lane = hw_lane(), tid = F.wave * 64 + lane;
    LAS unsigned char* Kl = F.lds; LAS unsigned char* Vl = F.lds + 65536;
    LAS float* lut = (LAS float*)(F.lds + ATT_LUT_OFF);
    LAS int* misc = (LAS int*)(F.lds + ATT_MISC_OFF);
    LAS int* prefix = (LAS int*)(F.lds + ATT_TAB_OFF); LAS int* ntile = (LAS int*)(F.lds + ATT_NT_OFF);
    const int r32 = lane & 31, hi = lane >> 5;
    {
        const int p = tid, h = p & 15, j = p >> 4;
        const int* c = F.CNT + ((size_t)h * NB + j) * NB; int n = 0;
#pragma unroll
        for (int q4 = 0; q4 < 8; ++q4) { const u32x4 v = *(const u32x4*)(c + 4 * q4);
            n += (4 * q4 + 0 > j ? (int)v.x : 0) + (4 * q4 + 1 > j ? (int)v.y : 0) + (4 * q4 + 2 > j ? (int)v.z : 0) + (4 * q4 + 3 > j ? (int)v.w : 0); }
        const int tiles = (n + 31) >> 5, groups = (tiles + TG - 1) / TG;
        int incl = groups;
#pragma unroll
        for (int o = 1; o < 64; o <<= 1) { const int y = __shfl_up(incl, o); if (lane >= o) incl += y; }
        if (lane == 63) misc[8 + F.wave] = incl;
        LDS_WAIT(); __syncthreads();
        int base = 0;
#pragma unroll
        for (int w2 = 0; w2 < 8; ++w2) if (w2 < F.wave) base += misc[8 + w2];
        prefix[p + 1] = base + incl; if (p == 0) prefix[0] = 0; ntile[p] = tiles;
        LDS_WAIT(); __syncthreads();
    }
    const int NITEMS = prefix[512];
    int nxt_item = 0;
    if (tid == 0) nxt_item = (int)__hip_atomic_fetch_add(F.ctl + cw_item, 1u, RLX_AGENT);
    for (;;) {
        if (tid == 0) misc[0] = nxt_item;
        LDS_WAIT(); __syncthreads();
        const int qi = __builtin_amdgcn_readfirstlane(misc[0]);
        constexpr int NCV = 256;
        const int NTOT = NITEMS + NCV;
        if (qi >= NTOT) break;
        if (tid == 0) nxt_item = (int)__hip_atomic_fetch_add(F.ctl + cw_item, 1u, RLX_AGENT);
        const int cvb = (int)(((long)qi * NCV) / NTOT), cva = (int)(((long)(qi + 1) * NCV) / NTOT);
        if (cva > cvb) {
            LAS unsigned* T = (LAS unsigned*)F.lds;
            const int lane2 = hw_lane(), tid2 = F.wave * 64 + lane2;
            for (int q = 0; q < 4; ++q) { const int r = 4 * cvb + q, nb = r & 15, kb = r >> 4; f32x4 v[8];
                p0_tile_load(v, F.w_out, DM, kb, nb, F.wave, lane2); p0_tile_out(v, F, F.WoutT, kb, nb, T, tid2, lane2); }
            continue;
        }
        const int item = qi - cvb;
        int plo = 0, phi = 512;
#pragma unroll
        for (int it = 0; it < 9; ++it) { const int mid = (plo + phi) >> 1; if (prefix[mid] <= item) plo = mid; else phi = mid; }
        const int p = __builtin_amdgcn_readfirstlane(plo), g = item - __builtin_amdgcn_readfirstlane(prefix[plo]);
        const int h = p & 15, j = p >> 4;
        if (F.wave == 0) {
            const int ln = hw_lane();
            int v = 0; if (ln < 32 && ln > j) v = F.CNT[((size_t)h * NB + j) * NB + ln];
            int incl = v;
#pragma unroll
            for (int o = 1; o < 32; o <<= 1) { const int y = __shfl_up(incl, o); if (ln >= o) incl += y; }
            if (ln < 32) misc[17 + ln] = incl; if (ln == 0) misc[16] = 0;
        }
        att_stage_kv(F, h, j, Kl, Vl, lut);
        LDS_WAIT(); __syncthreads();
        const LAS int* pre = misc + 16;
        const int n = pre[32];
        const float c31 = F.rel_bias[31 * NH + h] * LOG2E;
        const int t_end = (g * TG + TG) < ntile[p] ? (g * TG + TG) : ntile[p];
        int t = g * TG + F.wave;
        for (; t < t_end; t += NWAVES) { TileMeta mA; bf16x8 qA[8]; p3_fetch(F, h, j, t, n, pre, r32, hi, mA, qA); p3_compute_store(F, h, Kl, Vl, lut, c31, mA, qA, r32, hi, lane); }
        __syncthreads();
    }
}

__device__ __forceinline__ void p3b_own_combine(Frame& F) {
    const int lane = hw_lane(), tid = F.wave * 64 + lane;
    LAS unsigned char* Kl = F.lds; LAS unsigned char* Vl = F.lds + 65536;
    LAS float* lut = (LAS float*)(F.lds + ATT_LUT_OFF);
    const int r32 = lane & 31, hi = lane >> 5;
    for (int p = F.vcu; p < NH * NB; p += F.G) {
        const int h = p & 15, qb = p >> 4;
        att_stage_kv(F, h, qb, Kl, Vl, lut);
        LDS_WAIT(); __syncthreads();
        const int ql = 32 * F.wave + r32, s = qb * BLK + ql;
        bf16x8 qr[8];
        const bf16_t* qp = F.PROJ + ((size_t)h * HSQ + s) * HD + 8 * hi;
#pragma unroll
        for (int st = 0; st < 8; ++st) qr[st] = *(const bf16x8*)(qp + 16 * st);
        const f32x4 L = *(const f32x4*)(F.LSE + ((size_t)h * SEQ + s) * 4);
        f32x16 o[4]; float m, l;
        att_tile<true>(Kl, Vl, lut + (ql + 255 - 4 * hi), 0.f, (F.wave >> 1) + 1, qr, r32, hi, lane, m, l, o);
        { auto rr = __builtin_amdgcn_permlane32_swap(__float_as_uint(l), __float_as_uint(l), false, false); l = __uint_as_float(rr[0]) + __uint_as_float(rr[1]); }
        const int nv = qb < 3 ? qb : 3;
        const float lse_own = m + __log2f(l);
        float M = lse_own;
#pragma unroll
        for (int r = 0; r < 3; ++r) if (r < nv) M = fmaxf(M, L[r]);
        float w[3]; float wo = __builtin_amdgcn_exp2f(lse_own - M); float wsum = wo;
#pragma unroll
        for (int r = 0; r < 3; ++r) { w[r] = (r < nv) ? __builtin_amdgcn_exp2f(L[r] - M) : 0.f; wsum += w[r]; }
        const float iw = 1.0f / wsum; wo = wo * iw / (l * 8.f);
#pragma unroll
        for (int r = 0; r < 3; ++r) w[r] *= iw * (1.f / 16.f);
        const unsigned char* pp = (const unsigned char*)F.PART + (((size_t)h * HSQ + s) * 4) * HD + 16 * hi;
        const unsigned char* zp = F.KVZ8 + ((size_t)(2 * NH + h) * HSQ + s) * HD + 16 * hi;
#pragma unroll
        for (int d0 = 0; d0 < 4; ++d0) for (int e = 0; e < 16; ++e) o[d0][e] *= wo;
#pragma unroll
        for (int r = 0; r < 3; ++r) if (r < nv) {
            u32x4 pv[4];
#pragma unroll
            for (int d0 = 0; d0 < 4; ++d0) pv[d0] = *(const u32x4*)(pp + r * HD + 32 * d0);
#pragma unroll
            for (int d0 = 0; d0 < 4; ++d0)
#pragma unroll
                for (int q4 = 0; q4 < 4; ++q4) { const int x = (int)pv[d0][q4]; const f32x2_t lo = __builtin_amdgcn_cvt_pk_f32_fp8(x, false), hi2 = __builtin_amdgcn_cvt_pk_f32_fp8(x, true);
                    o[d0][4 * q4 + 0] += w[r] * lo[0]; o[d0][4 * q4 + 1] += w[r] * lo[1]; o[d0][4 * q4 + 2] += w[r] * hi2[0]; o[d0][4 * q4 + 3] += w[r] * hi2[1]; }
        }
        {
            u32x4 zv[4];
#pragma unroll
            for (int d0 = 0; d0 < 4; ++d0) zv[d0] = *(const u32x4*)(zp + 32 * d0);
            unsigned char* mp8 = (unsigned char*)F.MIX + (size_t)s * (2 * DM) + h * HD + 16 * hi;
#define MIX8(v, zz) __builtin_amdgcn_fmed3f((v) * silu_f((zz) * 0.125f) * 16.f, -448.f, 448.f)
#pragma unroll
            for (int d0 = 0; d0 < 4; ++d0) { u32x4 ov;
#pragma unroll
                for (int q4 = 0; q4 < 4; ++q4) { const int zx = (int)zv[d0][q4]; const f32x2_t zl = __builtin_amdgcn_cvt_pk_f32_fp8(zx, false), zh = __builtin_amdgcn_cvt_pk_f32_fp8(zx, true);
                    int w0 = __builtin_amdgcn_cvt_pk_fp8_f32(MIX8(o[d0][4 * q4], zl[0]), MIX8(o[d0][4 * q4 + 1], zl[1]), 0, false);
                    w0 = __builtin_amdgcn_cvt_pk_fp8_f32(MIX8(o[d0][4 * q4 + 2], zh[0]), MIX8(o[d0][4 * q4 + 3], zh[1]), w0, true); ov[q4] = (unsigned)w0; }
                *(u32x4*)(mp8 + 32 * d0) = ov; }
#undef MIX8
        }
        __syncthreads();
    }
}

__device__ __forceinline__ void p4_mix(Frame& F) {
    const int lane = hw_lane(), tid = F.wave * 64 + lane;
    const int gt = F.vcu * 512 + tid, NT = F.G * 512;
    for (int idx = gt; idx < 128 * 2 * 512; idx += NT) {
        const int ch = 4 * (idx & 511), rr = (idx >> 9) & 1, st = idx >> 10;
        const float* bz = F.BZT + (((size_t)st * 2 + rr) * 3) * 2048 + ch;
        const f32x4 bg = *(const f32x4*)bz, z = *(const f32x4*)(bz + 2048), t0 = *(const f32x4*)(bz + 4096);
        const f32x4 zero = {0.f, 0.f, 0.f, 0.f};
        const f32x4 p63 = st ? *(const f32x4*)(F.TH + ((size_t)(st - 1) * 2 + 1) * 2048 + ch) : zero;
        const f32x4 p62 = st ? *(const f32x4*)(F.TH + ((size_t)(st - 1) * 2 + 0) * 2048 + ch) : zero;
        const f32x4 own0 = *(const f32x4*)(F.BZT + (((size_t)st * 2 + 0) * 3 + 2) * 2048 + ch);
        const f32x4 t1 = rr ? own0 : p63, t2 = rr ? p63 : p62;
        const f32x4 w0 = *(const f32x4*)(F.conv_w + ch), w1 = *(const f32x4*)(F.conv_w + 2048 + ch), w2 = *(const f32x4*)(F.conv_w + 4096 + ch);
        const f32x4 y = w0 * t2 + w1 * t1 + w2 * t0;
        u32x2 o; o.x = cvtpk(bg[0] * y[0] * silu_f(z[0]), bg[1] * y[1] * silu_f(z[1])); o.y = cvtpk(bg[2] * y[2] * silu_f(z[2]), bg[3] * y[3] * silu_f(z[3]));
        *(u32x2*)(F.MIX + (size_t)(st * 64 + rr) * DM + AW + ch) = o;
    }
}

__device__ __forceinline__ void p6_final(Frame& F) {
    const int lane = hw_lane(), tid = F.wave * 64 + lane;
    const int gw = F.vcu * NWAVES + F.wave, NGW = F.G * NWAVES;
    for (int row = gw; row < SEQ; row += NGW) {
        const float ss = wave_sum(F.ROWSS[(size_t)row * 64 + lane]);
        const float rstd = 1.0f / sqrtf(ss * (1.f / DM) + EPS);
        f32x4* orow = (f32x4*)(F.out + (size_t)row * DM) + lane; const f32x4* gr = (const f32x4*)F.fg + lane;
        f32x4 v[16];
#pragma unroll
        for (int j = 0; j < 16; ++j) v[j] = orow[64 * j];
#pragma unroll
        for (int j = 0; j < 16; ++j) { const f32x4 g = gr[64 * j]; f32x4 r; r[0] = v[j][0] * rstd * g[0]; r[1] = v[j][1] * rstd * g[1]; r[2] = v[j][2] * rstd * g[2]; r[3] = v[j][3] * rstd * g[3]; orow[64 * j] = r; }
    }
}

struct Args { const float* x; const float* ng; const float* w_in; const float* conv_w; const float* w_out; const float* rel_bias; const float* fg; float* out; unsigned char* ws; int ph_lo, ph_hi; };
__global__ void __launch_bounds__(NWAVES * 64, 2) mk_fwd(Args args) {
    extern __shared__ __attribute__((aligned(16))) unsigned char lds[];
    Frame F;
    F.lds = (LAS unsigned char*)lds;
    F.MISC = (volatile LAS unsigned*)(F.lds + MISC_OFF);
    F.wave = __builtin_amdgcn_readfirstlane((int)(threadIdx.x >> 6));
    F.G = gridDim.x; { const int bx = blockIdx.x; F.vcu = (F.G % 8 == 0) ? (bx % 8) * (F.G / 8) + bx / 8 : bx; }
    unsigned char* ws = args.ws;
    F.ctl = (unsigned*)(ws + WS_CTL);
    F.x = args.x; F.ng = args.ng; F.w_in = args.w_in; F.conv_w = args.conv_w; F.w_out = args.w_out; F.rel_bias = args.rel_bias; F.fg = args.fg; F.out = args.out;
    F.WinT = (bf16_t*)(ws + WS_WIN); F.WoutT = (bf16_t*)(ws + WS_WOUT); F.U = (bf16_t*)(ws + WS_U); F.PROJ = (bf16_t*)(ws + WS_PROJ); F.MIX = (bf16_t*)(ws + WS_MIX); F.PART = (bf16_t*)(ws + WS_PART);
    F.W8 = ws + WS_W8; F.U8 = ws + WS_U8; F.KVZ8 = ws + WS_KVZ8; F.TH = (float*)(ws + WS_TH); F.BZT = (float*)(ws + WS_BZT);
    F.LSE = (float*)(ws + WS_LSE); F.KSUM = (float*)(ws + WS_KSUM); F.ROWSS = (float*)(ws + WS_ROWSS); F.LIST = (unsigned short*)(ws + WS_LIST); F.CNT = (int*)(ws + WS_CNT);
    for (int u = threadIdx.x; u < (LDS_BYTES - LDSCTL_OFF) / 4; u += NWAVES * 64) ((LAS unsigned*)(F.lds + LDSCTL_OFF))[u] = 0u;
    __syncthreads();
    XcdBarrier bar; bar.bar = F.ctl + CW_BAR; bar.x = 0; bar.st = nullptr;
    if (N_LAUNCHES == 1) bar = xcd_barrier_post(F.ctl + CW_BAR, F.MISC + 8);
#define GRID_BAR() do { if (N_LAUNCHES == 1) xcd_barrier(bar); } while (0)
    const int lo = args.ph_lo, hi = args.ph_hi;
#define IN(k) (lo <= (k) && (k) < hi)
#define BOTH(k) (IN(k) && IN((k) + 1))
    if (IN(0)) { p0_prologue(F); if (BOTH(0)) GRID_BAR(); }
    if (IN(1)) {
        {
            pg8::Gemm g{F.U8, F.W8, SEQ, 8192, 4096, 32}; pg8::StaticOrder S; S.init(SEQ, 8192, F.G, (int)blockIdx.x);
            pg8::EpiProj E{F.PROJ, AW, F.KSUM, F.KVZ8};
            pg8::gemm_phase<pg8::EpiProj, pg8::StaticOrder, true, true, true>(F.lds, g, S, E, F.wave);
        }
        {
            pg8::Gemm g{F.U, F.WinT + (size_t)8192 * DM, SEQ, 8192, 8192, 64}; pg8::StaticOrder S; S.init(SEQ, 8192, F.G, (int)blockIdx.x);
            pg8::EpiConv E{F.MIX, F.conv_w, F.TH, F.BZT};
            pg8::gemm_phase<pg8::EpiConv, pg8::StaticOrder, true, true, false>(F.lds, g, S, E, F.wave);
        }
        if (BOTH(1)) GRID_BAR();
    }
    if (IN(2)) { p2_route(F); if (BOTH(2)) GRID_BAR(); }
    if (IN(3)) { p3a_selected(F, CW_ITEM); if (BOTH(3)) GRID_BAR(); }
    if (IN(4)) { p3b_own_combine(F); p4_mix(F); if (BOTH(4)) GRID_BAR(); }
    if (IN(5)) {
        pg8::Gemm g{F.MIX, F.WoutT, SEQ, DM, 8192, 48};
        pg8::StaticOrder S; S.init(SEQ, DM, F.G, (int)blockIdx.x);
        pg8::Unit u0, u1; const bool two = S.next(0, u0) && S.next(1, u1) && !S.next(2, u1) && S.next(1, u1) && u0.pm == u1.pm;
        if (F.G == 256) {
            const int c = (int)blockIdx.x, xcd = c & 7, off = c >> 3;
            for (int r = 0; r < 2; ++r) {
                pg8::OneUnit S1; S1.u.pm = 8 * (xcd >> 1) + 4 * r + (off & 3); S1.u.pn = 8 * (xcd & 1) + (off >> 2);
                pg8::EpiOutNorm E{F.x, F.out, F.ROWSS, F.fg, F.ctl + CW_PANEL, F.ctl + CW_TMO, -1, F.PART, 16u};
                pg8::gemm_phase<pg8::EpiOutNorm, pg8::OneUnit, true, true, false, 16>(F.lds, g, S1, E, F.wave);
                __syncthreads();
            }
        } else if (two) {
            pg8::EpiOutNorm E{F.x, F.out, F.ROWSS, F.fg, F.ctl + CW_PANEL, F.ctl + CW_TMO, u0.pn, F.PART, 8u};
            pg8::gemm_phase<pg8::EpiOutNorm, pg8::StaticOrder, true, true, false, 16>(F.lds, g, S, E, F.wave);
        } else {
            pg8::EpiOut E{F.x, F.out, F.ROWSS};
            pg8::gemm_phase<pg8::EpiOut, pg8::StaticOrder, true, true, false, 16>(F.lds, g, S, E, F.wave);
            GRID_BAR(); p6_final(F);
        }
    }
#undef IN
#undef BOTH
}

extern "C" void kernel_launch(void* const* d_in, const int* in_sizes, int n_in, void* d_out, int out_size, void* d_ws, size_t ws_size, hipStream_t stream) {
    static int grid = 0;
    if (grid == 0) {
        if (n_in != 7 || in_sizes[0] != SEQ * DM || out_size != SEQ * DM || ws_size < WS_END) {
            fprintf(stderr, "kernel_launch: unexpected shapes (n_in %d, in0 %d, out %d, ws %zu); nothing launched\n", n_in, n_in > 0 ? in_sizes[0] : -1, out_size, ws_size); grid = -1; return; }
        int dev = 0, cus = 0, per_cu = 0;
        if (hipGetDevice(&dev) != hipSuccess || hipDeviceGetAttribute(&cus, hipDeviceAttributeMultiprocessorCount, dev) != hipSuccess) { fprintf(stderr, "kernel_launch: device query failed\n"); grid = -1; return; }
        if (hipFuncSetAttribute((const void*)mk_fwd, hipFuncAttributeMaxDynamicSharedMemorySize, LDS_BYTES) != hipSuccess) { fprintf(stderr, "kernel_launch: hipFuncSetAttribute failed\n"); grid = -1; return; }
        if (hipOccupancyMaxActiveBlocksPerMultiprocessor(&per_cu, (const void*)mk_fwd, NWAVES * 64, LDS_BYTES) != hipSuccess || per_cu < 1) {
            fprintf(stderr, "kernel_launch: occupancy query reports %d workgroups per CU\n", per_cu); (void)hipGetLastError(); grid = -1; return; }
        grid = cus;
    }
    if (grid < 0) return;
    (void)hipMemsetAsync((char*)d_ws + WS_CTL, 0, CTL_ZERO_BYTES, stream);
    Args a{};
    a.x = (const float*)d_in[0]; a.ng = (const float*)d_in[1]; a.w_in = (const float*)d_in[2]; a.conv_w = (const float*)d_in[3]; a.w_out = (const float*)d_in[4];
    a.rel_bias = (const float*)d_in[5]; a.fg = (const float*)d_in[6]; a.out = (float*)d_out; a.ws = (unsigned char*)d_ws;
    if (N_LAUNCHES == 1) { a.ph_lo = 0; a.ph_hi = N_PHASES; hipLaunchKernelGGL(mk_fwd, dim3(grid), dim3(NWAVES * 64), LDS_BYTES, stream, a); }
    else { for (int p = 0; p < N_PHASES; ++p) { a.ph_lo = p; a.ph_hi = p + 1; hipLaunchKernelGGL(mk_fwd, dim3(grid), dim3(NWAVES * 64), LDS_BYTES, stream, a); } }
}
```

```cpp
#include <hip/hip_runtime.h>
#include <cstdio>
#include <cstdint>
#include <cmath>

#ifndef MK_DOUBLE
#define MK_DOUBLE -1
#endif
#ifndef MK_N_LAUNCHES
#define MK_N_LAUNCHES 1
#endif

#define LAS __attribute__((address_space(3)))
#define GAS __attribute__((address_space(1)))
typedef unsigned short bf16_t;
typedef short bf16x8 __attribute__((ext_vector_type(8)));
typedef short s16x4 __attribute__((ext_vector_type(4)));
typedef float f32x4 __attribute__((ext_vector_type(4)));
typedef float f32x16 __attribute__((ext_vector_type(16)));
typedef unsigned u32x4 __attribute__((ext_vector_type(4)));
typedef unsigned u32x2 __attribute__((ext_vector_type(2)));
typedef float f32x2_t __attribute__((ext_vector_type(2)));
typedef __bf16 bf16x2_t __attribute__((ext_vector_type(2)));

constexpr int HSQ = 8192 + 16;
constexpr int SEQ = 8192, DM = 4096, PW = 16384, AW = 2048, NH = 16, HD = 128, BLK = 256, NB = 32;
constexpr int COL_Q = 0, COL_K = 2048, COL_V = 4096, COL_ZA = 6144, COL_HC = 8192, COL_BG = 10240, COL_CG = 12288, COL_ZC = 14336;
constexpr float EPS = 1e-6f;
constexpr float LOG2E = 1.4426950408889634f;
constexpr float QK_C = 0.08838834764831845f * LOG2E / 8.f;

__device__ __forceinline__ unsigned cvtpk(float lo, float hi) { f32x2_t v = {lo, hi}; bf16x2_t b = __builtin_convertvector(v, bf16x2_t); return __builtin_bit_cast(unsigned, b); }
__device__ __forceinline__ float bf_lo(unsigned w) { return __uint_as_float(w << 16); }
__device__ __forceinline__ float bf_hi(unsigned w) { return __uint_as_float(w & 0xffff0000u); }
__device__ __forceinline__ float silu_f(float z) { return z * __builtin_amdgcn_rcpf(1.f + __builtin_amdgcn_exp2f(-LOG2E * z)); }
__device__ __forceinline__ int hw_lane() { int l; asm volatile("v_mbcnt_lo_u32_b32 %0, -1, 0\n\tv_mbcnt_hi_u32_b32 %0, -1, %0" : "=v"(l)); return l; }
__device__ __forceinline__ int crow(int r, int hi) { return (r & 3) + 8 * (r >> 2) + 4 * hi; }

namespace pg8 {
#define PG8_LAS __attribute__((address_space(3)))
__device__ __forceinline__ void glds16s(const void* sbase, unsigned voff, unsigned lds_dst) {
    unsigned keep;
    asm volatile("s_mov_b32 %0, m0\n\ts_mov_b32 m0, %3\n\ts_nop 0\n\tglobal_load_lds_dwordx4 %1, %2\n\ts_mov_b32 m0, %0" : "=&s"(keep) : "v"(voff), "s"(sbase), "s"(lds_dst) : "memory");
}
constexpr int BM = 256, BK = 64, HALF = 128, HTB = HALF * BK * 2, STAGE_BYTES = 8 * HTB, NXCD = 8, WGM = 8;
__host__ __device__ __forceinline__ int lds_byte(int r, int c) { const int st = (r >> 4) * 2 + (c >> 5), rr = r & 15, cc = c & 31, ob = rr * 64 + cc * 2; return st * 1024 + (ob ^ (((ob >> 9) & 1) << 5)); }
__host__ __device__ __forceinline__ void stage_rc(int b, int& R, int& C) { const int st = b / 1024, sb = b % 1024, swz = sb ^ (((sb >> 9) & 1) << 5); R = (st >> 1) * 16 + swz / 64; C = (st & 1) * 32 + (swz % 64) / 2; }
__host__ __device__ __forceinline__ int perm32(int rho) { const int n = rho >> 4, i = rho & 15; return 8 * (i >> 2) + 4 * n + (i & 3); }

struct Unit { int pm, pn; };
struct Gemm { const void* A; const void* Bt; int M, N, pitch, nt; const void* X = nullptr; };

struct StaticOrder {
    int nM, nN, nwg, G, c, skip_from, skip_by;
    __host__ __device__ __forceinline__ void init(int M, int N, int G_, int c_, int sf = 1 << 30, int sb = 0) { nM = M / BM; nN = N / BM; nwg = nM * nN; G = G_; c = c_; skip_from = sf; skip_by = sb; }
    __host__ __device__ __forceinline__ bool next(int i, Unit& u) const {
        const long L = (long)i * G + c; if (L >= nwg) return false;
        int wgid = (int)L; { const int q = nwg / NXCD, r = nwg % NXCD, xcd = wgid % NXCD, off = wgid / NXCD; wgid = (xcd < r ? xcd * (q + 1) : r * (q + 1) + (xcd - r) * q) + off; }
        const int nig = WGM * nN, gid = wgid / nig, fm = gid * WGM, gsz = (nM - fm) < WGM ? (nM - fm) : WGM;
        u.pm = fm + ((wgid % nig) % gsz); u.pn = (wgid % nig) / gsz; if (u.pn >= skip_from) u.pn += skip_by; return true;
    }
    __device__ __forceinline__ void a_ready(const Unit&) const {}
    __device__ __forceinline__ void done(const Unit&) const {}
};

struct EpiProj {
    static constexpr int PERM = 2; static constexpr bool AFTER_DRAIN = false;
    bf16_t* O; int ldc; float* ksum; unsigned char* O8;
    __device__ __forceinline__ void operator()(const f32x4 (&acc)[2][2][4][2], const Unit& u, int wr, int wc, int fr, int fq) const {
        const int row0 = u.pm * BM + wr * 64 + fr; const int col0 = u.pn * BM + wc * 64 + 16 * fq;
        if (u.pn < 8) {
#pragma unroll
        for (int ai = 0; ai < 2; ++ai)
#pragma unroll
            for (int m = 0; m < 4; ++m) { bf16_t* rowp = O + ((size_t)(col0 >> 7) * HSQ + (row0 + ai * HALF + m * 16)) * 128 + (col0 & 127);
#pragma unroll
                for (int bj = 0; bj < 2; ++bj) { const f32x4 v0 = acc[ai][bj][m][0], v1 = acc[ai][bj][m][1];
                    u32x4 w; w.x = cvtpk(v0[0], v0[1]); w.y = cvtpk(v0[2], v0[3]); w.z = cvtpk(v1[0], v1[1]); w.w = cvtpk(v1[2], v1[3]);
                    *(u32x4*)(rowp + bj * 8) = w; } }
        } else {
#define F8C(x) __builtin_amdgcn_fmed3f((x) * 8.f, -448.f, 448.f)
#pragma unroll
        for (int ai = 0; ai < 2; ++ai)
#pragma unroll
            for (int m = 0; m < 4; ++m) { unsigned char* rowp = O8 + ((size_t)((col0 - 2048) >> 7) * HSQ + (row0 + ai * HALF + m * 16)) * 128 + (col0 & 127); u32x4 w;
#pragma unroll
                for (int bj = 0; bj < 2; ++bj) { const f32x4 v0 = acc[ai][bj][m][0], v1 = acc[ai][bj][m][1];
                    int w0 = __builtin_amdgcn_cvt_pk_fp8_f32(F8C(v0[0]), F8C(v0[1]), 0, false); w0 = __builtin_amdgcn_cvt_pk_fp8_f32(F8C(v0[2]), F8C(v0[3]), w0, true);
                    int w1 = __builtin_amdgcn_cvt_pk_fp8_f32(F8C(v1[0]), F8C(v1[1]), 0, false); w1 = __builtin_amdgcn_cvt_pk_fp8_f32(F8C(v1[2]), F8C(v1[3]), w1, true);
                    w[2 * bj] = (unsigned)w0; w[2 * bj + 1] = (unsigned)w1; }
                *(u32x4*)rowp = w; }
#undef F8C
        }
        if (ksum && u.pn >= 8 && u.pn < 16) {
            float* kp = ksum + (size_t)u.pm * 2048 + (u.pn - 8) * BM + wc * 64 + 16 * fq;
#pragma unroll
            for (int bj = 0; bj < 2; ++bj)
#pragma unroll
                for (int n = 0; n < 2; ++n) {
                    f32x4 s = acc[0][bj][0][n];
#pragma unroll
                    for (int m = 1; m < 4; ++m) s += acc[0][bj][m][n];
#pragma unroll
                    for (int m = 0; m < 4; ++m) s += acc[1][bj][m][n];
#pragma unroll
                    for (int j = 0; j < 4; ++j) { float v = s[j]; v += __shfl_xor(v, 1); v += __shfl_xor(v, 2); v += __shfl_xor(v, 4); v += __shfl_xor(v, 8);
                        if (fr == 0) atomicAdd(kp + 8 * bj + 4 * n + j, v); }
                }
        }
    }
};
template <int CTRL> __device__ __forceinline__ float dpp1(float v) { return __builtin_bit_cast(float, __builtin_amdgcn_update_dpp(0, __builtin_bit_cast(int, v), CTRL, 0xf, 0xf, false)); }
template <int CTRL> __device__ __forceinline__ f32x4 dpp_ror(const f32x4 v) { f32x4 r; r.x = dpp1<CTRL>(v.x); r.y = dpp1<CTRL>(v.y); r.z = dpp1<CTRL>(v.z); r.w = dpp1<CTRL>(v.w); return r; }
struct EpiConv {
    static constexpr bool PERM = true, AFTER_DRAIN = false, PREFETCH = true;
    bf16_t* MIXp; const float* cw; float* TH; float* BZT; const float* RSTD;
    struct Pre { f32x4 w0, w1, w2; float rs[2][4]; };
    __device__ __forceinline__ void prefetch(Pre& P, const Unit& u, int wr, int wc, int fr, int fq) const {
        const int ch = u.pn * 64 + wc * 16 + fq * 4;
        P.w0 = *(const f32x4*)(cw + ch); P.w1 = *(const f32x4*)(cw + 2048 + ch); P.w2 = *(const f32x4*)(cw + 4096 + ch);
#pragma unroll
        for (int ai = 0; ai < 2; ++ai)
#pragma unroll
            for (int m = 0; m < 4; ++m) P.rs[ai][m] = RSTD[(u.pm * 4 + ai * 2 + wr) * 64 + m * 16 + fr];
    }
    __device__ __forceinline__ void operator()(const f32x4 (&acc)[2][2][4][2], const Pre& P, const Unit& u, int wr, int wc, int fr, int fq) const {
        const int ch = u.pn * 64 + wc * 16 + fq * 4;
        const f32x4 w0 = P.w0, w1 = P.w1, w2 = P.w2;
#pragma unroll
        for (int ai = 0; ai < 2; ++ai) {
            const int strip = u.pm * 4 + ai * 2 + wr;
            f32x4 t[4], r1[4], r2[4]; float rs[4];
#pragma unroll
            for (int m = 0; m < 4; ++m) rs[m] = P.rs[ai][m];
#pragma unroll
            for (int m = 0; m < 4; ++m) { t[m] = acc[ai][1][m][0] * acc[ai][0][m][0] * (rs[m] * rs[m]); r1[m] = dpp_ror<0x121>(t[m]); r2[m] = dpp_ror<0x122>(t[m]); }
#pragma unroll
            for (int m = 0; m < 4; ++m) {
                const f32x4 p1 = m ? r1[m - 1] : (f32x4){0.f, 0.f, 0.f, 0.f}, p2 = m ? r2[m - 1] : (f32x4){0.f, 0.f, 0.f, 0.f};
                f32x4 t1, t2;
#pragma unroll
                for (int j = 0; j < 4; ++j) { t1[j] = fr == 0 ? p1[j] : r1[m][j]; t2[j] = fr < 2 ? p2[j] : r2[m][j]; }
                const f32x4 y = w0 * t2 + w1 * t1 + w2 * t[m]; const f32x4 bg = acc[ai][0][m][1] * rs[m], z = acc[ai][1][m][1] * rs[m];
                u32x2 o; o.x = cvtpk(bg[0] * y[0] * silu_f(z[0]), bg[1] * y[1] * silu_f(z[1])); o.y = cvtpk(bg[2] * y[2] * silu_f(z[2]), bg[3] * y[3] * silu_f(z[3]));
                if (m != 0 || fr >= 2) *(u32x2*)(MIXp + (size_t)(strip * 64 + m * 16 + fr) * DM + AW + ch) = o;
            }
            if (fr >= 14) *(f32x4*)(TH + ((size_t)strip * 2 + (fr - 14)) * 2048 + ch) = t[3];
            if (fr < 2) { float* bz = BZT + (((size_t)strip * 2 + fr) * 3) * 2048 + ch; *(f32x4*)(bz) = acc[ai][0][0][1] * rs[0]; *(f32x4*)(bz + 2048) = acc[ai][1][0][1] * rs[0]; *(f32x4*)(bz + 4096) = t[0]; }
        }
    }
};
struct EpiOut {
    static constexpr bool PERM = false, AFTER_DRAIN = false;
    const float* X; float* out; float* rowss;
    __device__ __forceinline__ void operator()(const f32x4 (&acc)[2][2][4][2], const Unit& u, int wr, int wc, int fr, int fq) const {
        const int col0 = u.pn * BM + wc * 32 + 4 * fq;
#pragma unroll
        for (int ai = 0; ai < 2; ++ai)
#pragma unroll
            for (int m = 0; m < 4; ++m) { const int row = u.pm * BM + ai * HALF + wr * 64 + m * 16 + fr; const size_t off = (size_t)row * DM + col0; float ss = 0.f;
#pragma unroll
                for (int bj = 0; bj < 2; ++bj)
#pragma unroll
                    for (int n = 0; n < 2; ++n) { const f32x4 xv = *(const f32x4*)(X + off + bj * HALF + n * 16); const f32x4 hv = xv + acc[ai][bj][m][n];
                        *(f32x4*)(out + off + bj * HALF + n * 16) = hv; ss += (hv[0] * hv[0] + hv[1] * hv[1]) + (hv[2] * hv[2] + hv[3] * hv[3]); }
                ss += __shfl_xor(ss, 16); ss += __shfl_xor(ss, 32);
                if (fq == 0) rowss[(size_t)row * 64 + u.pn * 4 + wc] = ss; }
    }
};

constexpr int F8_SCALE_W = 0x78787878, F8_SCALE_U = 0x7D7D7D7D;
typedef int v4i_t __attribute__((ext_vector_type(4)));
typedef int v8i_t __attribute__((ext_vector_type(8)));
struct OneUnit { Unit u;
    __device__ __forceinline__ bool next(int i, Unit& o) const { if (i != 0) return false; o = u; return true; }
    __device__ __forceinline__ void a_ready(const Unit&) const {}
    __device__ __forceinline__ void done(const Unit&) const {}
};
struct EpiOutNorm {
    static constexpr bool PERM = false, AFTER_DRAIN = true;
    const bf16_t* X; float* out; float* rowss; const float* fg; unsigned* cnt; unsigned* tmo; int pn0; bf16_t* H0; unsigned target; bool xin;
    __device__ __forceinline__ bf16_t* h0_piece(int pm, int pn, int wr, int wc, int fr, int fq) const { return H0 + ((size_t)(pm * 16 + pn) << 16) + ((wr * 4 + wc) << 13) + ((fq * 16 + fr) << 3); }
    __device__ __forceinline__ void tile_h(f32x4 (&acc)[2][2][4][2], const Unit& u, int wr, int wc, int fr, int fq, bool store, PG8_LAS float* red = nullptr) const {
        const int col0 = u.pn * BM + wc * 32 + 4 * fq;
#pragma unroll
        for (int ai = 0; ai < 2; ++ai) {
            const int row0 = u.pm * BM + ai * HALF + wr * 64 + fr;
            u32x2 xw[4][2][2];
#pragma unroll
            for (int m = 0; m < 4; ++m)
#pragma unroll
                for (int bj = 0; bj < 2; ++bj)
#pragma unroll
                    for (int n = 0; n < 2; ++n) { if (xin) xw[m][bj][n] = (u32x2){0u, 0u}; else xw[m][bj][n] = __builtin_nontemporal_load((const u32x2*)(X + (size_t)(row0 + m * 16) * DM + col0 + bj * HALF + n * 16)); }
            asm volatile("" ::: "memory");
            float ssv[4];
#pragma unroll
            for (int m = 0; m < 4; ++m) { float ss = 0.f;
#pragma unroll
                for (int bj = 0; bj < 2; ++bj) { u32x4 hb;
#pragma unroll
                    for (int n = 0; n < 2; ++n) { const u32x2 xq = xw[m][bj][n]; const f32x4 hv = (f32x4){bf_lo(xq.x), bf_hi(xq.x), bf_lo(xq.y), bf_hi(xq.y)} + acc[ai][bj][m][n]; acc[ai][bj][m][n] = hv;
                        hb[2 * n] = cvtpk(hv[0], hv[1]); hb[2 * n + 1] = cvtpk(hv[2], hv[3]); ss += (hv[0] * hv[0] + hv[1] * hv[1]) + (hv[2] * hv[2] + hv[3] * hv[3]); }
                    if (store) *(u32x4*)(h0_piece(u.pm, u.pn, wr, wc, fr, fq) + (((ai * 4 + m) * 2 + bj) << 9)) = hb; }
                ss += __shfl_xor(ss, 16); ss += __shfl_xor(ss, 32); ssv[m] = ss; }
            if (fq == 0) {
#pragma unroll
                for (int m = 0; m < 4; ++m) { if (red) red[((ai * HALF + wr * 64 + m * 16 + fr) << 2) + wc] = ssv[m];
                    else __hip_atomic_store(rowss + (size_t)(row0 + m * 16) * 64 + u.pn * 4 + wc, ssv[m], __ATOMIC_RELAXED, __HIP_MEMORY_SCOPE_AGENT); } }
            asm volatile("" ::: "memory");
        }
    }
    __device__ __forceinline__ void operator()(const f32x4 (&acc)[2][2][4][2], const Unit& u, int wr, int wc, int fr, int fq) const {
        f32x4 (&a)[2][2][4][2] = const_cast<f32x4 (&)[2][2][4][2]>(acc);
        tile_h(a, u, wr, wc, fr, fq, true);
    }
    __device__ __forceinline__ void fused(f32x4 (&acc)[2][2][4][2], const Unit& u, int wr, int wc, int fr, int fq, PG8_LAS unsigned char* lds, int wid, int lane) const {
        PG8_LAS float* S = (PG8_LAS float*)lds;
        PG8_LAS unsigned* flag = (PG8_LAS unsigned*)(lds + 2048);
        PG8_LAS float* red = xin ? (PG8_LAS float*)(lds + 4096) : nullptr;
        tile_h(acc, u, wr, wc, fr, fq, false, red);
        if (xin) {
            asm volatile("s_waitcnt lgkmcnt(0)" ::: "memory"); __builtin_amdgcn_s_barrier(); asm volatile("" ::: "memory");
            const int t2 = wid * 64 + lane;
            if (t2 < 256) { const f32x4 q4 = *(const PG8_LAS f32x4*)(red + 4 * t2); __hip_atomic_store(rowss + (size_t)(u.pm * BM + t2) * 64 + u.pn, (q4[0] + q4[1]) + (q4[2] + q4[3]), __ATOMIC_RELAXED, __HIP_MEMORY_SCOPE_AGENT); }
        }
        asm volatile("s_waitcnt vmcnt(0)" ::: "memory");
        __builtin_amdgcn_s_barrier(); asm volatile("" ::: "memory");
        unsigned* c = cnt + 64 * u.pm;
        if (wid == 0) {
            if (lane == 0) __hip_atomic_fetch_add(c, 1u, __ATOMIC_RELAXED, __HIP_MEMORY_SCOPE_AGENT);
            unsigned spins = 0; bool dead = false;
            while ((unsigned)__builtin_amdgcn_readfirstlane((int)__hip_atomic_load(c, __ATOMIC_RELAXED, __HIP_MEMORY_SCOPE_AGENT)) < target) {
                __builtin_amdgcn_s_sleep(2);
                if (++spins > (1u << 22)) { dead = true; break; } }
            if (lane == 0) { flag[0] = dead ? 1u : 0u; if (dead) __hip_atomic_store(tmo, 1u, __ATOMIC_RELAXED, __HIP_MEMORY_SCOPE_AGENT); }
        }
        asm volatile("s_waitcnt vmcnt(0) lgkmcnt(0)" ::: "memory"); __builtin_amdgcn_s_barrier(); asm volatile("" ::: "memory");
        { const int tid = wid * 64 + lane, row = tid >> 1, hf = tid & 1; const float* rp = rowss + (size_t)(u.pm * BM + row) * 64 + (xin ? 8 : 32) * hf; float s = 0.f;
          if (xin) { f32x4 v0, v1;
            asm volatile("global_load_dwordx4 %0, %2, off sc1\n\tglobal_load_dwordx4 %1, %2, off offset:16 sc1\n\ts_waitcnt vmcnt(0)" : "=&v"(v0), "=&v"(v1) : "v"(rp) : "memory");
            s += (v0[0] + v0[1]) + (v0[2] + v0[3]); s += (v1[0] + v1[1]) + (v1[2] + v1[3]); }
          else { f32x4 v0, v1, v2, v3, v4, v5, v6, v7;
            asm volatile("global_load_dwordx4 %0, %8, off sc1\n\tglobal_load_dwordx4 %1, %8, off offset:16 sc1\n\tglobal_load_dwordx4 %2, %8, off offset:32 sc1\n\tglobal_load_dwordx4 %3, %8, off offset:48 sc1\n\t"
                         "global_load_dwordx4 %4, %8, off offset:64 sc1\n\tglobal_load_dwordx4 %5, %8, off offset:80 sc1\n\tglobal_load_dwordx4 %6, %8, off offset:96 sc1\n\tglobal_load_dwordx4 %7, %8, off offset:112 sc1\n\t"
                         "s_waitcnt vmcnt(0)" : "=&v"(v0), "=&v"(v1), "=&v"(v2), "=&v"(v3), "=&v"(v4), "=&v"(v5), "=&v"(v6), "=&v"(v7) : "v"(rp) : "memory");
            s += (v0[0] + v0[1]) + (v0[2] + v0[3]); s += (v1[0] + v1[1]) + (v1[2] + v1[3]); s += (v2[0] + v2[1]) + (v2[2] + v2[3]); s += (v3[0] + v3[1]) + (v3[2] + v3[3]);
            s += (v4[0] + v4[1]) + (v4[2] + v4[3]); s += (v5[0] + v5[1]) + (v5[2] + v5[3]); s += (v6[0] + v6[1]) + (v6[2] + v6[3]); s += (v7[0] + v7[1]) + (v7[2] + v7[3]); }
          s += __shfl_xor(s, 1);
          if (hf == 0) S[row] = 1.0f / sqrtf(s * (1.f / DM) + 1e-6f); }
        asm volatile("s_waitcnt lgkmcnt(0)" ::: "memory"); __builtin_amdgcn_s_barrier(); asm volatile("" ::: "memory");
        {
            const int col0 = u.pn * BM + wc * 32 + 4 * fq;
            f32x4 g[2][2];
#pragma unroll
            for (int bj = 0; bj < 2; ++bj)
#pragma unroll
                for (int n = 0; n < 2; ++n) g[bj][n] = *(const f32x4*)(fg + col0 + bj * HALF + n * 16);
#pragma unroll
            for (int ai = 0; ai < 2; ++ai)
#pragma unroll
                for (int m = 0; m < 4; ++m) { const int r = ai * HALF + wr * 64 + m * 16 + fr; const float rs = S[r]; const size_t off = (size_t)(u.pm * BM + r) * DM + col0;
#pragma unroll
                    for (int bj = 0; bj < 2; ++bj)
#pragma unroll
                        for (int n = 0; n < 2; ++n) *(f32x4*)(out + off + bj * HALF + n * 16) = acc[ai][bj][m][n] * rs * g[bj][n]; }
        }
        asm volatile("" ::: "memory");
        if (pn0 >= 0) {
            const int col0 = pn0 * BM + wc * 32 + 4 * fq;
            u32x4 hb[2][4][2];
            const bf16_t* hp = h0_piece(u.pm, pn0, wr, wc, fr, fq);
#pragma unroll
            for (int ai = 0; ai < 2; ++ai)
#pragma unroll
                for (int m = 0; m < 4; ++m)
#pragma unroll
                    for (int bj = 0; bj < 2; ++bj) hb[ai][m][bj] = *(const u32x4*)(hp + (((ai * 4 + m) * 2 + bj) << 9));
            f32x4 g[2][2];
#pragma unroll
            for (int bj = 0; bj < 2; ++bj)
#pragma unroll
                for (int n = 0; n < 2; ++n) g[bj][n] = *(const f32x4*)(fg + col0 + bj * HALF + n * 16);
            asm volatile("" ::: "memory");
#pragma unroll
            for (int ai = 0; ai < 2; ++ai)
#pragma unroll
                for (int m = 0; m < 4; ++m) { const int r = ai * HALF + wr * 64 + m * 16 + fr; const float rs = S[r]; const size_t off = (size_t)(u.pm * BM + r) * DM + col0;
#pragma unroll
                    for (int bj = 0; bj < 2; ++bj)
#pragma unroll
                        for (int n = 0; n < 2; ++n) { const u32x4 h4 = hb[ai][m][bj]; const f32x4 hv = (f32x4){bf_lo(h4[2 * n]), bf_hi(h4[2 * n]), bf_lo(h4[2 * n + 1]), bf_hi(h4[2 * n + 1])};
                            *(f32x4*)(out + off + bj * HALF + n * 16) = hv * rs * g[bj][n]; } }
        }
    }
};
template <class T, class = void> struct PreOf { struct type {}; static constexpr bool value = false; };
template <class T> struct PreOf<T, decltype((void)T::PREFETCH)> { using type = typename T::Pre; static constexpr bool value = true; };
template <class T> constexpr bool pre_v = PreOf<T>::value;
template <class Epi, class Sched, bool ALIGN_EPI = false, bool SP2 = false, bool F8 = false, int MIXK = 0, int XK = 0>
__device__ __forceinline__ void gemm_phase(PG8_LAS unsigned char* lds, const Gemm g, const Sched& S, const Epi& E, int wid) {
    const int lane = hw_lane(), tid = wid * 64 + lane, wr = wid >> 2, wc = wid & 3, fr = lane & 15, fq = lane >> 4;
    const int pitch = g.pitch, nt = g.nt;
    constexpr int SCALE_A8 = MIXK > 0 ? 0x7B7B7B7B : F8_SCALE_U;
#define PG8_KOFS(t) ((size_t)(t) * 128 + ((MIXK > 0 && (t) >= MIXK) ? 2048 : 0))
    unsigned voffA[2], voffB[2];
#pragma unroll
    for (int i = 0; i < 2; ++i) { int R, C; stage_rc(tid * 16 + i * 8192, R, C); const int Rb = (int)Epi::PERM == 2 ? (64 * (R >> 5) + 16 * ((R >> 2) & 3) + 4 * ((R >> 4) & 1) + (R & 3)) : Epi::PERM ? ((R & ~31) + perm32(R & 31)) : R;
        voffA[i] = (unsigned)(R * pitch + C * 2); voffB[i] = (unsigned)(Rb * pitch + C * 2); }
    const size_t kstep = (size_t)(BK * 2);
    const size_t hstep = (size_t)HALF * pitch;
    const size_t tstep = 2 * hstep;
    const size_t hstepB = (int)Epi::PERM == 2 ? (size_t)8 * pitch : hstep;
    const unsigned ldsb = (unsigned)__builtin_amdgcn_readfirstlane((int)((unsigned)(uintptr_t)lds + (unsigned)wid * 1024u));
    const int aoff = lds_byte(wr * 64 + fr, fq * 8), boff = lds_byte(wc * 32 + fr, fq * 8);
#define PG8_SA(b, h) (((b) * 2 + (h)) * HTB)
#define PG8_SB(b, h) ((4 + (b) * 2 + (h)) * HTB)
#define PG8_STAGE(bufoff, gbase, voff) do { _Pragma("unroll") for (int _i = 0; _i < 2; ++_i) \
        glds16s((const void*)(gbase), (voff)[_i], ldsb + (unsigned)((bufoff) + _i * 8192)); } while (0)
#define PG8_LDA(dst, b, h) do { _Pragma("unroll") for (int m = 0; m < 4; ++m) _Pragma("unroll") for (int k = 0; k < 2; ++k) dst[m][k] = *(const PG8_LAS bf16x8*)(lds + PG8_SA(b, h) + aoff + m * 2048 + k * 1024); } while (0)
#define PG8_LDB(dst, b, h) do { _Pragma("unroll") for (int n = 0; n < 2; ++n) _Pragma("unroll") for (int k = 0; k < 2; ++k) dst[n][k] = *(const PG8_LAS bf16x8*)(lds + PG8_SB(b, h) + boff + n * 2048 + k * 1024); } while (0)
#define PG8_MMA(ai, bj, At, Bt) do { __builtin_amdgcn_s_setprio(1); _Pragma("unroll") for (int k = 0; k < 2; ++k) _Pragma("unroll") for (int m = 0; m < 4; ++m) _Pragma("unroll") for (int n = 0; n < 2; ++n) \
        acc[ai][bj][m][n] = __builtin_amdgcn_mfma_f32_16x16x32_bf16(Bt[n][k], At[m][k], acc[ai][bj][m][n], 0, 0, 0); __builtin_amdgcn_s_setprio(0); } while (0)
#define PG8_CAT(x0, x1) __builtin_shufflevector(__builtin_bit_cast(v4i_t, x0), __builtin_bit_cast(v4i_t, x1), 0, 1, 2, 3, 4, 5, 6, 7)
#define PG8_MMA8(ai, bj, At, Bt) do { __builtin_amdgcn_s_setprio(1); _Pragma("unroll") for (int m = 0; m < 4; ++m) _Pragma("unroll") for (int n = 0; n < 2; ++n) \
        acc[ai][bj][m][n] = __builtin_amdgcn_mfma_scale_f32_16x16x128_f8f6f4(PG8_CAT(Bt[n][0], Bt[n][1]), PG8_CAT(At[m][0], At[m][1]), acc[ai][bj][m][n], 0, 0, 0, F8_SCALE_W, 0, SCALE_A8); __builtin_amdgcn_s_setprio(0); } while (0)
#define PG8_MM(ai, bj, At, Bt) do { if constexpr (F8) PG8_MMA8(ai, bj, At, Bt); else PG8_MMA(ai, bj, At, Bt); } while (0)
#define PG8_WAIT_V(n) asm volatile("s_waitcnt vmcnt(" #n ")" ::: "memory")
#define PG8_WAIT_L(n) asm volatile("s_waitcnt lgkmcnt(" #n ")" ::: "memory")
#define PG8_BAR __builtin_amdgcn_s_barrier()
#define PG8_SCHED __builtin_amdgcn_sched_barrier(0)
    Unit cur, nxt; int ui = 0;
    if (!S.next(0, cur)) return;
    f32x4 acc[2][2][4][2];
#pragma unroll
    for (int a = 0; a < 2; ++a)
#pragma unroll
        for (int b = 0; b < 2; ++b)
#pragma unroll
            for (int m = 0; m < 4; ++m)
#pragma unroll
                for (int n = 0; n < 2; ++n) acc[a][b][m][n] = (f32x4){0.f, 0.f, 0.f, 0.f};
    bf16x8 At[4][2], B0[2][2], B1[2][2];
    const char* cA = (const char*)g.A + (size_t)cur.pm * tstep; const char* cB = (const char*)g.Bt + (size_t)cur.pn * tstep;
    typename PreOf<Epi>::type pre; if constexpr (pre_v<Epi>) E.prefetch(pre, cur, wr, wc, fr, fq);
    S.a_ready(cur);
    if constexpr (SP2) {
        PG8_STAGE(PG8_SB(0, 0), cB, voffB); PG8_STAGE(PG8_SB(0, 1), cB + hstepB, voffB); PG8_STAGE(PG8_SA(0, 0), cA, voffA); PG8_STAGE(PG8_SA(0, 1), cA + hstep, voffA);
        if (wr == 1) PG8_BAR;
        PG8_WAIT_V(2); PG8_BAR;
        PG8_STAGE(PG8_SB(1, 0), cB + kstep, voffB); PG8_STAGE(PG8_SA(1, 0), cA + kstep, voffA); PG8_STAGE(PG8_SB(1, 1), cB + hstepB + kstep, voffB);
        PG8_WAIT_V(6); PG8_BAR;
    } else {
        PG8_STAGE(PG8_SB(0, 0), cB, voffB); PG8_STAGE(PG8_SA(0, 0), cA, voffA); PG8_STAGE(PG8_SB(0, 1), cB + hstepB, voffB); PG8_STAGE(PG8_SA(0, 1), cA + hstep, voffA);
        if (wr == 1) PG8_BAR;
        PG8_WAIT_V(4); PG8_BAR;
        PG8_STAGE(PG8_SB(1, 0), cB + kstep, voffB); PG8_STAGE(PG8_SA(1, 0), cA + kstep, voffA); PG8_STAGE(PG8_SB(1, 1), cB + hstepB + kstep, voffB);
        PG8_WAIT_V(6); PG8_BAR;
    }
    for (;;) {
        const bool has_next = S.next(ui + 1, nxt);
        const char* nA = has_next ? (const char*)g.A + (size_t)nxt.pm * tstep : cA; const char* nB = has_next ? (const char*)g.Bt + (size_t)nxt.pn * tstep : cB;
        if constexpr (MIXK > 0) {
            static_assert(SP2 && !F8, "mixed K needs the SP2 schedule");
            for (int t = 0; t < MIXK; t += 2) {
            const bool last = (t == nt - 2);
            const char* a1 = cA + PG8_KOFS(t + 1);
            const char* a2 = last ? nA : cA + PG8_KOFS(t + 2); const char* b2 = last ? nB : cB + PG8_KOFS(t + 2);
            const char* a3 = a2 + kstep; const char* b3 = b2 + kstep;
            if (last && has_next) S.a_ready(nxt);
            PG8_LDB(B0, 0, 0); PG8_LDB(B1, 0, 1); PG8_SCHED; PG8_LDA(At, 0, 0); PG8_STAGE(PG8_SA(1, 1), a1 + hstep, voffA);
            PG8_WAIT_V(8); PG8_WAIT_L(0); PG8_BAR; PG8_MMA8(0, 0, At, B0); PG8_MMA8(0, 1, At, B1); PG8_BAR; PG8_SCHED;
            PG8_LDA(At, 0, 1); PG8_STAGE(PG8_SB(0, 0), b2, voffB); PG8_STAGE(PG8_SB(0, 1), b2 + hstepB, voffB); PG8_STAGE(PG8_SA(0, 0), a2, voffA);
            PG8_WAIT_V(8); PG8_WAIT_L(0); PG8_BAR; PG8_MMA8(1, 0, At, B0); PG8_MMA8(1, 1, At, B1); PG8_BAR; PG8_SCHED;
            PG8_LDB(B0, 1, 0); PG8_LDB(B1, 1, 1); PG8_SCHED; PG8_LDA(At, 1, 0); PG8_STAGE(PG8_SA(0, 1), a2 + hstep, voffA);
            PG8_WAIT_V(8); PG8_WAIT_L(0); PG8_BAR; PG8_MMA8(0, 0, At, B0); PG8_MMA8(0, 1, At, B1); PG8_BAR; PG8_SCHED;
            PG8_LDA(At, 1, 1); PG8_STAGE(PG8_SB(1, 0), b3, voffB); PG8_STAGE(PG8_SB(1, 1), b3 + hstepB, voffB); PG8_STAGE(PG8_SA(1, 0), a3, voffA);
            PG8_WAIT_V(8); PG8_WAIT_L(0); PG8_BAR; PG8_MMA8(1, 0, At, B0); PG8_MMA8(1, 1, At, B1); PG8_BAR; PG8_SCHED;
            }
            const int ntm = nt - XK;
            const char* xA = XK > 0 ? (const char*)g.X + (size_t)cur.pm * tstep + (size_t)cur.pn * 512 : cA;
#define PG8_A_AT(t) ((XK > 0 && (t) >= ntm) ? xA + (size_t)((t) - ntm) * 128 : cA + PG8_KOFS(t))
#define PG8_B_AT(t) ((XK > 0 && (t) >= ntm) ? cB + 2048 + (size_t)((t) - ntm) * 128 : cB + PG8_KOFS(t))
            for (int t = MIXK; t < nt; t += 2) {
            const bool last = (t == nt - 2);
            const char* a1 = PG8_A_AT(t + 1);
            const char* a2 = last ? nA : PG8_A_AT(t + 2); const char* b2 = last ? nB : PG8_B_AT(t + 2);
            const char* a3 = a2 + kstep; const char* b3 = b2 + kstep;
            if (last && has_next) S.a_ready(nxt);
            PG8_LDB(B0, 0, 0); PG8_LDB(B1, 0, 1); PG8_SCHED; PG8_LDA(At, 0, 0); PG8_STAGE(PG8_SA(1, 1), a1 + hstep, voffA);
            PG8_WAIT_V(8); PG8_WAIT_L(0); PG8_BAR; PG8_MMA(0, 0, At, B0); PG8_MMA(0, 1, At, B1); PG8_BAR; PG8_SCHED;
            PG8_LDA(At, 0, 1); PG8_STAGE(PG8_SB(0, 0), b2, voffB); PG8_STAGE(PG8_SB(0, 1), b2 + hstepB, voffB); PG8_STAGE(PG8_SA(0, 0), a2, voffA);
            PG8_WAIT_V(8); PG8_WAIT_L(0); PG8_BAR; PG8_MMA(1, 0, At, B0); PG8_MMA(1, 1, At, B1); PG8_BAR; PG8_SCHED;
            PG8_LDB(B0, 1, 0); PG8_LDB(B1, 1, 1); PG8_SCHED; PG8_LDA(At, 1, 0); PG8_STAGE(PG8_SA(0, 1), a2 + hstep, voffA);
            PG8_WAIT_V(8); PG8_WAIT_L(0); PG8_BAR; PG8_MMA(0, 0, At, B0); PG8_MMA(0, 1, At, B1); PG8_BAR; PG8_SCHED;
            PG8_LDA(At, 1, 1); PG8_STAGE(PG8_SB(1, 0), b3, voffB); PG8_STAGE(PG8_SB(1, 1), b3 + hstepB, voffB); PG8_STAGE(PG8_SA(1, 0), a3, voffA);
            PG8_WAIT_V(8); PG8_WAIT_L(0); PG8_BAR; PG8_MMA(1, 0, At, B0); PG8_MMA(1, 1, At, B1); PG8_BAR; PG8_SCHED;
            }
        } else {
        for (int t = 0; t < nt; t += 2) {
            const bool last = (t == nt - 2);
            const char* a1 = cA + PG8_KOFS(t + 1);
            const char* a2 = last ? nA : cA + PG8_KOFS(t + 2); const char* b2 = last ? nB : cB + PG8_KOFS(t + 2);
            const char* a3 = a2 + kstep; const char* b3 = b2 + kstep;
            if (last && has_next) S.a_ready(nxt);
            if constexpr (SP2) {
            PG8_LDB(B0, 0, 0); PG8_LDB(B1, 0, 1); PG8_SCHED; PG8_LDA(At, 0, 0); PG8_STAGE(PG8_SA(1, 1), a1 + hstep, voffA);
            PG8_WAIT_V(8); PG8_WAIT_L(0); PG8_BAR; PG8_MM(0, 0, At, B0); PG8_MM(0, 1, At, B1); PG8_BAR; PG8_SCHED;
            PG8_LDA(At, 0, 1); PG8_STAGE(PG8_SB(0, 0), b2, voffB); PG8_STAGE(PG8_SB(0, 1), b2 + hstepB, voffB); PG8_STAGE(PG8_SA(0, 0), a2, voffA);
            PG8_WAIT_V(8); PG8_WAIT_L(0); PG8_BAR; PG8_MM(1, 0, At, B0); PG8_MM(1, 1, At, B1); PG8_BAR; PG8_SCHED;
            PG8_LDB(B0, 1, 0); PG8_LDB(B1, 1, 1); PG8_SCHED; PG8_LDA(At, 1, 0); PG8_STAGE(PG8_SA(0, 1), a2 + hstep, voffA);
            PG8_WAIT_V(8); PG8_WAIT_L(0); PG8_BAR; PG8_MM(0, 0, At, B0); PG8_MM(0, 1, At, B1); PG8_BAR; PG8_SCHED;
            PG8_LDA(At, 1, 1); PG8_STAGE(PG8_SB(1, 0), b3, voffB); PG8_STAGE(PG8_SB(1, 1), b3 + hstepB, voffB); PG8_STAGE(PG8_SA(1, 0), a3, voffA);
            PG8_WAIT_V(8); PG8_WAIT_L(0); PG8_BAR; PG8_MM(1, 0, At, B0); PG8_MM(1, 1, At, B1); PG8_BAR; PG8_SCHED;
            } else {
            PG8_LDB(B0, 0, 0); PG8_SCHED; PG8_LDA(At, 0, 0); PG8_STAGE(PG8_SA(1, 1), a1 + hstep, voffA);
            PG8_WAIT_L(8); PG8_BAR; PG8_WAIT_L(0); PG8_MM(0, 0, At, B0); PG8_BAR; PG8_SCHED;
            PG8_LDB(B1, 0, 1); PG8_STAGE(PG8_SB(0, 0), b2, voffB);
            PG8_BAR; PG8_WAIT_L(0); PG8_MM(0, 1, At, B1); PG8_BAR;
            PG8_LDA(At, 0, 1); PG8_STAGE(PG8_SA(0, 0), a2, voffA);
            PG8_BAR; PG8_WAIT_L(0); PG8_MM(1, 0, At, B0); PG8_BAR; PG8_SCHED;
            PG8_STAGE(PG8_SB(0, 1), b2 + hstepB, voffB);
            PG8_WAIT_V(6); PG8_BAR; PG8_MM(1, 1, At, B1); PG8_BAR;
            PG8_LDB(B0, 1, 0); PG8_SCHED; PG8_LDA(At, 1, 0); PG8_STAGE(PG8_SA(0, 1), a2 + hstep, voffA);
            PG8_WAIT_L(8); PG8_BAR; PG8_WAIT_L(0); PG8_MM(0, 0, At, B0); PG8_BAR; PG8_SCHED;
            PG8_LDB(B1, 1, 1); PG8_STAGE(PG8_SB(1, 0), b3, voffB);
            PG8_BAR; PG8_WAIT_L(0); PG8_MM(0, 1, At, B1); PG8_BAR;
            PG8_LDA(At, 1, 1); PG8_STAGE(PG8_SA(1, 0), a3, voffA);
            PG8_BAR; PG8_WAIT_L(0); PG8_MM(1, 0, At, B0); PG8_BAR; PG8_SCHED;
            PG8_STAGE(PG8_SB(1, 1), b3 + hstepB, voffB);
            PG8_WAIT_V(6); PG8_BAR; PG8_MM(1, 1, At, B1); PG8_BAR;
            }
        }
        }
        if constexpr (ALIGN_EPI) { if (wr == 0) PG8_BAR; }
        { const int le = hw_lane();
          if constexpr (pre_v<Epi>) { E(acc, pre, cur, wr, wc, le & 15, le >> 4); S.done(cur); }
          else if constexpr (!Epi::AFTER_DRAIN) { E(acc, cur, wr, wc, le & 15, le >> 4); S.done(cur); }
          else { if (has_next) { E(acc, cur, wr, wc, le & 15, le >> 4); S.done(cur); } } }
        if (!has_next) break;
#pragma unroll
        for (int a = 0; a < 2; ++a)
#pragma unroll
            for (int b = 0; b < 2; ++b)
#pragma unroll
                for (int m = 0; m < 4; ++m)
#pragma unroll
                    for (int n = 0; n < 2; ++n) acc[a][b][m][n] = (f32x4){0.f, 0.f, 0.f, 0.f};
        cur = nxt; cA = nA; cB = nB; ++ui;
        if constexpr (pre_v<Epi>) { const int le = hw_lane(); E.prefetch(pre, cur, wr, wc, le & 15, le >> 4); }
        if constexpr (ALIGN_EPI) { if (wr == 1) PG8_BAR; }
    }
    PG8_WAIT_V(0);
    if constexpr (!ALIGN_EPI) { if (wr == 0) PG8_BAR; }
    PG8_BAR;
    if constexpr (Epi::AFTER_DRAIN) { const int le = hw_lane(); E.fused(acc, cur, wr, wc, le & 15, le >> 4, lds, wid, le); S.done(cur); }
#undef PG8_SA
#undef PG8_SB
#undef PG8_STAGE
#undef PG8_LDA
#undef PG8_LDB
#undef PG8_MMA
#undef PG8_MMA8
#undef PG8_MM
#undef PG8_CAT
#undef PG8_KOFS
#undef PG8_A_AT
#undef PG8_B_AT
#undef PG8_WAIT_V
#undef PG8_WAIT_L
#undef PG8_BAR
#undef PG8_SCHED
}
}

constexpr int NWAVES = 8;
constexpr int N_LAUNCHES = MK_N_LAUNCHES;
constexpr int N_PHASES = 6;

constexpr size_t MiB = 1u << 20;
constexpr size_t WS_CTL = 0, CTL_ZERO_BYTES = 64 * 1024;
constexpr size_t WS_WIN = 2 * MiB;
constexpr size_t WS_WOUT = 130 * MiB;
constexpr size_t WS_U = 162 * MiB;
constexpr size_t WS_PROJ = 226 * MiB;
constexpr size_t WS_MIX = 482 * MiB;
constexpr size_t WS_PART = 546 * MiB;
constexpr size_t WS_LSE = 674 * MiB;
constexpr size_t WS_KSUM = 676 * MiB;
constexpr size_t WS_LIST = 677 * MiB;
constexpr size_t WS_CNT = 685 * MiB;
constexpr size_t WS_ROWSS = 686 * MiB;
constexpr size_t WS_W8 = 688 * MiB;
constexpr size_t WS_U8 = 720 * MiB;
constexpr size_t WS_TH = 752 * MiB;
constexpr size_t WS_BZT = 754 * MiB;
constexpr size_t WS_KVZ8 = 760 * MiB;
constexpr size_t WS_RSTD = 809 * MiB;
constexpr size_t WS_END = 810 * MiB;
constexpr int CW_BAR = 4096;
constexpr int CW_ITEM = 64;
constexpr int CW_PANEL = 8192;
constexpr int CW_TMO = 2;

constexpr int RING_BYTES = 131072;
constexpr int LDSCTL_OFF = RING_BYTES, MISC_OFF = LDSCTL_OFF + 320;
constexpr int ATT_LUT_OFF = RING_BYTES + 1024;
constexpr int ATT_MISC_OFF = ATT_LUT_OFF + 3072;
constexpr int LDS_BYTES = 147456;

typedef GAS unsigned gu32;
#define RLX_AGENT __ATOMIC_RELAXED, __HIP_MEMORY_SCOPE_AGENT
#define LDS_WAIT() asm volatile("s_waitcnt lgkmcnt(0)" ::: "memory")
#define VM_WAIT() asm volatile("s_waitcnt vmcnt(0)" ::: "memory")
#define LDS_BARRIER() do { asm volatile("s_waitcnt lgkmcnt(0)" ::: "memory"); __builtin_amdgcn_s_barrier(); asm volatile("" ::: "memory"); } while (0)

#define XB_TMO      128
#define XB_XCNT(j)  (256  + 64 * (j))
#define XB_XSUB(j)  (1280 + 64 * (j))
#define XB_XGEN(j)  (2304 + 64 * (j))
#define XB_TOP      3328
#define XB_TOPGEN   3392
#define XCD_BAR_WORDS 3456
#define XB_SPIN_CAP (1u << 20)
__device__ __forceinline__ unsigned xb_ld(unsigned* p)              { return __hip_atomic_load(p, __ATOMIC_RELAXED, __HIP_MEMORY_SCOPE_AGENT); }
__device__ __forceinline__ unsigned xb_add(unsigned* p, unsigned v) { return __hip_atomic_fetch_add(p, v, __ATOMIC_RELAXED, __HIP_MEMORY_SCOPE_AGENT); }
__device__ __forceinline__ unsigned xb_xcc_id() { return (unsigned)__builtin_amdgcn_s_getreg((3 << 11) | 20) & 0xFu; }
#define XB_SPIN(cond, bar) do { unsigned _sp = 0; while (cond) { __builtin_amdgcn_s_sleep(1); \
    if ((++_sp & 255u) == 0u) { if (xb_ld(&(bar)[XB_TMO])) break; if (_sp > XB_SPIN_CAP) { atomicAdd(&(bar)[XB_TMO], 1u); break; } } } } while (0)
struct XcdBarrier { unsigned* bar; unsigned x; volatile LAS unsigned* st; };
__device__ __forceinline__ XcdBarrier xcd_barrier_post(unsigned* bar, volatile LAS unsigned* st) {
    XcdBarrier b; b.bar = bar; b.x = xb_xcc_id(); b.st = st;
    if (threadIdx.x == 0) (void)xb_add(&bar[XB_XCNT(b.x)], 1u);
    return b;
}
__device__ __forceinline__ void xcd_barrier_complete(unsigned* bar, unsigned x, unsigned& nloc, unsigned& nx) {
    const unsigned G = gridDim.x * gridDim.y * gridDim.z;
    unsigned sum, cnt, mine, sp = 0u;
    for (;;) {
        sum = 0u; cnt = 0u; mine = 0u;
#pragma unroll
        for (unsigned j = 0; j < 16; ++j) { const unsigned c = xb_ld(&bar[XB_XCNT(j)]); sum += c; cnt += (c > 0u) ? 1u : 0u; mine = (j == x) ? c : mine; }
        if (sum == G) break;
        __builtin_amdgcn_s_sleep(1);
        if ((++sp & 255u) == 0u) { if (xb_ld(&bar[XB_TMO])) break; if (sp > XB_SPIN_CAP) { atomicAdd(&bar[XB_TMO], 1u); break; } }
    }
    nloc = mine > 0u ? mine : 1u; nx = cnt > 0u ? cnt : 1u;
}
__device__ __forceinline__ void xcd_barrier(const XcdBarrier& b) {
    asm volatile("s_waitcnt vmcnt(0)" ::: "memory");
    __syncthreads();
    if (threadIdx.x == 0) {
        unsigned* bar = b.bar;
        __builtin_amdgcn_s_waitcnt(0);
        unsigned nloc = b.st[0], nx = b.st[1];
        if (nloc == 0u) { xcd_barrier_complete(bar, b.x, nloc, nx); b.st[0] = nloc; b.st[1] = nx; }
        const unsigned old = xb_add(&bar[XB_XSUB(b.x)], 1u);
        const unsigned gen = old / nloc;
        if (old + 1u == (gen + 1u) * nloc) {
            __builtin_amdgcn_fence(__ATOMIC_RELEASE, "agent");
            asm volatile("s_waitcnt vmcnt(0)" ::: "memory");
            const unsigned og = xb_add(&bar[XB_TOP], 1u);
            asm volatile("buffer_inv sc1" ::: "memory");
            const unsigned tg = og / nx;
            if (og + 1u == (tg + 1u) * nx) xb_add(&bar[XB_TOPGEN], 1u);
            else XB_SPIN(xb_ld(&bar[XB_TOPGEN]) == tg, bar);
            xb_add(&bar[XB_XGEN(b.x)], 1u);
            asm volatile("s_waitcnt vmcnt(0)" ::: "memory");
        } else {
            asm volatile("buffer_inv sc1" ::: "memory");
            XB_SPIN(xb_ld(&bar[XB_XGEN(b.x)]) == gen, bar);
            asm volatile("s_waitcnt vmcnt(0)" ::: "memory");
        }
    }
    __syncthreads();
}

struct Frame {
    LAS unsigned char* lds;
    volatile LAS unsigned* MISC;
    unsigned* ctl;
    int wave, vcu, G;
    const float *x, *ng, *w_in, *conv_w, *w_out, *rel_bias, *fg; float* out;
    bf16_t *WinT, *WoutT, *U, *PROJ, *MIX, *PART; unsigned char *W8, *U8, *KVZ8; float *TH, *BZT; float *LSE, *KSUM, *ROWSS, *RSTD; unsigned short* LIST; int* CNT;
};

__device__ __forceinline__ float wave_sum(float v) {
#pragma unroll
    for (int o = 1; o < 64; o <<= 1) v += __shfl_xor(v, o);
    return v;
}

__device__ __forceinline__ int hperm(int d) { return 32 * (d >> 5) + 16 * ((d >> 2) & 1) + 4 * ((d >> 3) & 3) + (d & 3); }
__device__ __forceinline__ void p0_tile_load(f32x4 (&v)[8], const float* W, int N, int kb, int nb, int wave, int lane) {
    const float* src = W + (size_t)(64 * kb + 8 * wave) * N + 256 * nb + 4 * lane;
#pragma unroll
    for (int i = 0; i < 8; ++i) v[i] = __builtin_nontemporal_load((const f32x4*)(src + (size_t)i * N));
}
template <bool KPERM, bool CPERM> __device__ __forceinline__ void p0_tile_store(const f32x4 (&v)[8], bf16_t* WT, int kb, int nb, LAS unsigned* T, int tid, int wave, int lane) {
#pragma unroll
    for (int ii = 0; ii < 4; ++ii) { const int kp = 4 * wave + ii; u32x4 d;
        d.x = cvtpk(v[2 * ii][0], v[2 * ii + 1][0]); d.y = cvtpk(v[2 * ii][1], v[2 * ii + 1][1]); d.z = cvtpk(v[2 * ii][2], v[2 * ii + 1][2]); d.w = cvtpk(v[2 * ii][3], v[2 * ii + 1][3]);
        *(LAS u32x4*)(T + kp * 256 + ((4 * lane) ^ (wave << 2))) = d; }
    LDS_BARRIER();
#pragma unroll
    for (int i = 0; i < 4; ++i) { const int idx = tid + 512 * i, n = idx >> 3, c = idx & 7; u32x4 o;
        const LAS unsigned* tp = T + (4 * c) * 256 + (n ^ (c << 2));
        o.x = tp[0]; o.y = tp[256]; o.z = tp[512]; o.w = tp[768];
        int R = 256 * nb + n; if (CPERM) { const int q = R - 8192, kind = q >> 11, chn = q & 2047, cl = chn & 63; R = 8192 + 256 * (chn >> 6) + 128 * (kind >> 1) + 32 * (cl >> 4) + 8 * ((cl >> 2) & 3) + 4 * (kind & 1) + (cl & 3); }
        bf16_t* rowp = WT + (size_t)R * 4096;
        if (KPERM) { const int kp = 128 * (kb >> 1) + 16 * (2 * (kb & 1) + (c >> 2)) + 4 * (c & 3); *(u32x2*)(rowp + kp) = (u32x2){o.x, o.y}; *(u32x2*)(rowp + kp + 64) = (u32x2){o.z, o.w}; }
        else *(u32x4*)(rowp + 64 * kb + 8 * c) = o; }
    LDS_BARRIER();
}
template <bool WOUT> __device__ __forceinline__ void p0_tile_store_f8(const f32x4 (&v)[8], unsigned char* W8, int kb, int nb8, LAS unsigned* T, int tid, int wave, int lane) {
#pragma unroll
    for (int q2 = 0; q2 < 2; ++q2) { const int kq = 2 * wave + q2; u32x4 d;
#pragma unroll
        for (int c = 0; c < 4; ++c) {
#define W8C(x) __builtin_amdgcn_fmed3f((x) * 128.f, -448.f, 448.f)
            int w32 = __builtin_amdgcn_cvt_pk_fp8_f32(W8C(v[4 * q2][c]), W8C(v[4 * q2 + 1][c]), 0, false); w32 = __builtin_amdgcn_cvt_pk_fp8_f32(W8C(v[4 * q2 + 2][c]), W8C(v[4 * q2 + 3][c]), w32, true); d[c] = (unsigned)w32;
#undef W8C
        }
        *(LAS u32x4*)(T + kq * 256 + ((4 * lane) ^ (((kq >> 2) & 3) << 3))) = d; }
    LDS_BARRIER();
#pragma unroll
    for (int i = 0; i < 2; ++i) { const int idx = tid + 512 * i, n = idx >> 2, c = idx & 3; u32x4 o;
        const LAS unsigned* tp = T + (4 * c) * 256 + (n ^ (c << 3));
        o.x = tp[0]; o.y = tp[256]; o.z = tp[512]; o.w = tp[768];
        if (WOUT) {
            unsigned char* rowp = W8 + (size_t)(256 * nb8 + n) * 8192 + 128 * (kb >> 1) + 32 * (2 * (kb & 1) + (c >> 1)) + 8 * (c & 1);
            *(u32x2*)(rowp) = (u32x2){o.x, o.z}; *(u32x2*)(rowp + 16) = (u32x2){o.y, o.w};
        } else {
        int R = 256 * nb8 + n; if (R >= COL_ZA) R = (R & ~127) + hperm(R & 127);
        *(u32x4*)(W8 + (size_t)R * 4096 + 64 * kb + 16 * c) = o; } }
    LDS_BARRIER();
}
__device__ __forceinline__ void p0_decode(int it, const float* w_in, const float* w_out, bf16_t* WinT, bf16_t* WoutT, const float*& W, int& N, bf16_t*& WT, int& kb, int& nb) {
    if (it < 4096) { W = w_in; N = PW; WT = WinT; nb = (it < 2048 ? 0 : 32) + (it & 31); kb = (it & 2047) >> 5; }
    else { const int r = it - 4096; W = w_out; N = DM; WT = WoutT; nb = r & 15; kb = r >> 4; }
}
__device__ __forceinline__ void p0_tile_out(const f32x4 (&v)[8], Frame& F, bf16_t* WT, int kb, int nb, LAS unsigned* T, int tid, int lane) {
    if (WT == F.WinT && nb < 32) p0_tile_store_f8<false>(v, F.W8, kb, nb, T, tid, F.wave, lane);
    else if (WT == F.WoutT && kb < 32) p0_tile_store_f8<true>(v, (unsigned char*)F.WoutT, kb, nb, T, tid, F.wave, lane);
    else if (WT == F.WinT) {
        f32x4 w[8];
#pragma unroll
        for (int i = 0; i < 8; ++i) w[i] = v[i] * F.ng[64 * kb + 8 * F.wave + i];
        p0_tile_store<false, true>(w, WT, kb, nb, T, tid, F.wave, lane); }
    else p0_tile_store<false, false>(v, WT, kb, nb, T, tid, F.wave, lane);
}
__device__ __forceinline__ void p0_prologue(Frame& F) {
    const int lane = hw_lane(), tid = F.wave * 64 + lane;
    { const int gt = F.vcu * 512 + tid, NT = F.G * 512;
      for (int i = gt; i < DM * 32; i += NT) { const int n = i >> 5, c = i & 31; u32x4 v = {0u, 0u, 0u, 0u};
          if (((n & 255) >> 3) == c) v[(n & 7) >> 1] = (n & 1) ? 0x3F800000u : 0x00003F80u;
          *(u32x4*)((unsigned char*)F.WoutT + (size_t)n * 8192 + 2048 + 16 * c) = v; } }
    { const int gt = F.vcu * 512 + tid, NT = F.G * 512; for (int i = gt; i < NB * 2048 / 4; i += NT) ((f32x4*)F.KSUM)[i] = (f32x4){0.f, 0.f, 0.f, 0.f}; }
    {
        LAS unsigned* T = (LAS unsigned*)F.lds;
        constexpr int NIT = 4096;
        f32x4 va[8], vb[8]; const float* W; int N, kb, nb; bf16_t* WT;
        int it = F.vcu;
        if (it < NIT) { p0_decode(it, F.w_in, F.w_out, F.WinT, F.WoutT, W, N, WT, kb, nb); p0_tile_load(va, W, N, kb, nb, F.wave, lane); }
        while (it < NIT) {
            const float* W2; int N2, kb2, nb2; bf16_t* WT2; const int it2 = it + F.G;
            if (it2 < NIT) { p0_decode(it2, F.w_in, F.w_out, F.WinT, F.WoutT, W2, N2, WT2, kb2, nb2); p0_tile_load(vb, W2, N2, kb2, nb2, F.wave, lane); }
            p0_tile_out(va, F, WT, kb, nb, T, tid, lane);
            it = it2; if (it >= NIT) break;
            const int it3 = it + F.G;
            if (it3 < NIT) { p0_decode(it3, F.w_in, F.w_out, F.WinT, F.WoutT, W, N, WT, kb, nb); p0_tile_load(va, W, N, kb, nb, F.wave, lane); }
            p0_tile_out(vb, F, WT2, kb2, nb2, T, tid, lane);
            it = it3;
        }
    }
    {
        const int gw = F.vcu * NWAVES + F.wave, NGW = F.G * NWAVES;
        f32x4 va[16], vb[16], gg[16];
        { const f32x4* gr0 = (const f32x4*)F.ng + lane;
#pragma unroll
          for (int j = 0; j < 16; ++j) gg[j] = gr0[64 * j]; }
#define ROW_LOAD(dst, row_) do { const f32x4* xr_ = (const f32x4*)(F.x + (size_t)(row_) * DM) + lane; _Pragma("unroll") for (int j = 0; j < 16; ++j) dst[j] = __builtin_nontemporal_load(xr_ + 64 * j); } while (0)
#define U8C(x) __builtin_amdgcn_fmed3f((x) * 4.f, -448.f, 448.f)
#define ROW_OUT(v, row_) do { float ss = 0.f; _Pragma("unroll") for (int j = 0; j < 16; ++j) ss += (v[j][0] * v[j][0] + v[j][1] * v[j][1]) + (v[j][2] * v[j][2] + v[j][3] * v[j][3]); \
            const float rstd = 1.0f / sqrtf(wave_sum(ss) * (1.f / DM) + EPS); \
            if (lane == 0) F.RSTD[row_] = rstd; \
            u32x2* o8 = (u32x2*)(F.U + (size_t)(row_) * DM) + lane; unsigned* o4 = (unsigned*)(F.U8 + (size_t)(row_) * DM) + lane; \
            _Pragma("unroll") for (int j = 0; j < 16; ++j) { const f32x4 g = gg[j]; const float u0 = v[j][0] * rstd * g[0], u1 = v[j][1] * rstd * g[1], u2 = v[j][2] * rstd * g[2], u3 = v[j][3] * rstd * g[3]; \
                u32x2 w; w.x = cvtpk(v[j][0], v[j][1]); w.y = cvtpk(v[j][2], v[j][3]); o8[64 * j] = w;        \
                int w8 = __builtin_amdgcn_cvt_pk_fp8_f32(U8C(u0), U8C(u1), 0, false); w8 = __builtin_amdgcn_cvt_pk_fp8_f32(U8C(u2), U8C(u3), w8, true); o4[64 * j] = (unsigned)w8; } } while (0)
        int row = gw;
        if (row < SEQ) ROW_LOAD(va, row);
        while (row < SEQ) {
            const int r2 = row + NGW;
            if (r2 < SEQ) ROW_LOAD(vb, r2);
            ROW_OUT(va, row);
            row = r2; if (row >= SEQ) break;
            const int r3 = row + NGW;
            if (r3 < SEQ) ROW_LOAD(va, r3);
            ROW_OUT(vb, row);
            row = r3;
        }
#undef ROW_LOAD
#undef ROW_OUT
#undef U8C
    }
}

#define TOP_BETTER(v, i, w, k) ((v) > (w) || ((v) == (w) && (i) < (k)))
#define TOP_INSERT(v, i) do { if (TOP_BETTER(v, i, v0, i0)) { v2 = v1; i2 = i1; v1 = v0; i1 = i0; v0 = (v); i0 = (i); } \
    else if (TOP_BETTER(v, i, v1, i1)) { v2 = v1; i2 = i1; v1 = (v); i1 = (i); } else if (TOP_BETTER(v, i, v2, i2)) { v2 = (v); i2 = (i); } } while (0)
__device__ __forceinline__ void p2_route(Frame& F) {
    const int lane = hw_lane(), tid = F.wave * 64 + lane;
    const int grp = F.wave >> 2, w4 = F.wave & 3, tl = tid & 255;
    LAS int* lcnt = (LAS int*)F.lds + 32 * grp;
    const int r32 = lane & 31, hi = lane >> 5;
    for (int pr = F.vcu; 2 * pr < NH * (NB - 1); pr += F.G) {
        const int u = 2 * pr + grp; const bool act = u < NH * (NB - 1);
        const int h = u & 15, qb = act ? 1 + (u >> 4) : 1;
        if (tl < 32) lcnt[tl] = 0;
        __syncthreads();
        if (act) {
            bf16x8 khi[8], klo[8];
            const float* kp = F.KSUM + (size_t)r32 * 2048 + h * HD + 8 * hi;
#pragma unroll
            for (int st = 0; st < 8; ++st) {
                const f32x4 a = *(const f32x4*)(kp + 16 * st), b = *(const f32x4*)(kp + 16 * st + 4);
                float f[8] = {a[0], a[1], a[2], a[3], b[0], b[1], b[2], b[3]}; u32x4 wh, wl; unsigned hh[4], ll[4];
#pragma unroll
                for (int e = 0; e < 4; ++e) { const float x0 = f[2 * e] * (1.f / 256.f), x1 = f[2 * e + 1] * (1.f / 256.f); const unsigned w = cvtpk(x0, x1); hh[e] = w; ll[e] = cvtpk(x0 - bf_lo(w), x1 - bf_hi(w)); }
                wh = (u32x4){hh[0], hh[1], hh[2], hh[3]}; wl = (u32x4){ll[0], ll[1], ll[2], ll[3]};
                khi[st] = __builtin_bit_cast(bf16x8, wh); klo[st] = __builtin_bit_cast(bf16x8, wl);
            }
            for (int half = 0; half < 2; ++half) {
                const int ql = 32 * (w4 + 4 * half) + r32, s = qb * BLK + ql;
                const bf16_t* qp = F.PROJ + ((size_t)h * HSQ + s) * HD + 8 * hi;
                bf16x8 q[8];
#pragma unroll
                for (int st = 0; st < 8; ++st) q[st] = *(const bf16x8*)(qp + 16 * st);
                f32x16 acc; for (int r = 0; r < 16; ++r) acc[r] = 0.f;
#pragma unroll
                for (int st = 0; st < 8; ++st) { acc = __builtin_amdgcn_mfma_f32_32x32x16_bf16(khi[st], q[st], acc, 0, 0, 0); acc = __builtin_amdgcn_mfma_f32_32x32x16_bf16(klo[st], q[st], acc, 0, 0, 0); }
                float v0 = -INFINITY, v1 = -INFINITY, v2 = -INFINITY; int i0 = 64, i1 = 65, i2 = 66;
#pragma unroll
                for (int r = 0; r < 16; ++r) { const int blk = crow(r, hi); const float v = (blk < qb) ? acc[r] : -INFINITY; TOP_INSERT(v, blk); }
                { const float p0 = __shfl_xor(v0, 32), p1 = __shfl_xor(v1, 32), p2 = __shfl_xor(v2, 32); const int j0 = __shfl_xor(i0, 32), j1 = __shfl_xor(i1, 32), j2 = __shfl_xor(i2, 32);
                  TOP_INSERT(p0, j0); TOP_INSERT(p1, j1); TOP_INSERT(p2, j2); }
                const int nv = qb < 3 ? qb : 3;
                if (hi == 0) {
                    const int sel[3] = {i0, i1, i2};
#pragma unroll
                    for (int r = 0; r < 3; ++r) if (r < nv) { const int n = sel[r]; const int pos = __hip_atomic_fetch_add(lcnt + n, 1, __ATOMIC_RELAXED, __HIP_MEMORY_SCOPE_WORKGROUP);
                        F.LIST[(((size_t)h * NB + n) * NB + qb) * BLK + pos] = (unsigned short)(s | (r << 13)); }
                }
            }
        }
        LDS_WAIT(); __syncthreads();
        if (act && tl < qb) F.CNT[((size_t)h * NB + tl) * NB + qb] = lcnt[tl];
        __syncthreads();
    }
}

template <bool GENERAL>
__device__ __forceinline__ void att_tile(const LAS unsigned char* Kl, const LAS unsigned char* Vl, const LAS float* lutp, float c31, int nkt,
                                         const bf16x8 (&qr)[8], int r32_, int hi_, int lane_, float& m_out, float& l_out, f32x16 (&o)[4]) {
    const int lane = hw_lane(), r32 = lane & 31, hi = lane >> 5;
    (void)r32_; (void)hi_; (void)lane_;
    float m = 0.f, l = 0.f;
#pragma unroll
    for (int d0 = 0; d0 < 4; ++d0) for (int r = 0; r < 16; ++r) o[d0][r] = 0.f;
    const int X = (r32 & 15) << 4;
    const int i16 = lane & 15, qq = i16 >> 2, pp = i16 & 3, blk = (lane >> 4) & 1;
    int vb[4];
#pragma unroll
    for (int d0 = 0; d0 < 4; ++d0) vb[d0] = 256 * (4 * hi + qq) + 16 * (4 * (d0 ^ qq) + 2 * blk + (pp >> 1)) + 8 * (pp & 1);
    for (int kt = 0; kt < nkt; ++kt) {
        f32x16 p0, p1;
#pragma unroll
        for (int r = 0; r < 16; ++r) { p0[r] = 0.f; p1[r] = 0.f; }
        const LAS unsigned char* kr = Kl + 256 * (64 * kt + r32);
#pragma unroll
        for (int st = 0; st < 8; ++st) {
            const int cb = (32 * st + 16 * hi) ^ X;
            const bf16x8 a0 = *(const LAS bf16x8*)(kr + cb), a1 = *(const LAS bf16x8*)(kr + 32 * 256 + cb);
            p0 = __builtin_amdgcn_mfma_f32_32x32x16_bf16(a0, qr[st], p0, 0, 0, 0);
            p1 = __builtin_amdgcn_mfma_f32_32x32x16_bf16(a1, qr[st], p1, 0, 0, 0);
        }
        if (GENERAL) {
            const LAS float* lp = lutp - 64 * kt;
#pragma unroll
            for (int r = 0; r < 16; ++r) { const int kk = (r & 3) + 8 * (r >> 2); p0[r] = fmaf(p0[r], QK_C, lp[-kk]) - m; p1[r] = fmaf(p1[r], QK_C, lp[-kk - 32]) - m; }
        } else {
            const float bm = c31 - m;
#pragma unroll
            for (int r = 0; r < 16; ++r) { p0[r] = fmaf(p0[r], QK_C, bm); p1[r] = fmaf(p1[r], QK_C, bm); }
        }
        float pa = __builtin_fmaxf(__builtin_fmaxf(p0[0], p0[1]), p1[0]), pb_ = __builtin_fmaxf(__builtin_fmaxf(p0[2], p0[3]), p1[1]); pa = __builtin_fmaxf(__builtin_fmaxf(pa, p1[2]), p1[3]);
#pragma unroll
        for (int r = 4; r < 16; r += 4) { pa = __builtin_fmaxf(__builtin_fmaxf(pa, p0[r]), p0[r + 1]); pb_ = __builtin_fmaxf(__builtin_fmaxf(pb_, p0[r + 2]), p0[r + 3]);
            pa = __builtin_fmaxf(__builtin_fmaxf(pa, p1[r]), p1[r + 1]); pb_ = __builtin_fmaxf(__builtin_fmaxf(pb_, p1[r + 2]), p1[r + 3]); }
        float pmax = __builtin_fmaxf(pa, pb_);
        { auto rr = __builtin_amdgcn_permlane32_swap(__float_as_uint(pmax), __float_as_uint(pmax), false, false); pmax = fmaxf(__uint_as_float(rr[0]), __uint_as_float(rr[1])); }
        if (kt == 0 || __any(pmax > 8.f)) {
            const float dl = kt == 0 ? pmax : fmaxf(pmax, 0.f);
            m += dl;
#pragma unroll
            for (int r = 0; r < 16; ++r) { p0[r] -= dl; p1[r] -= dl; }
            if (kt > 0) {
                const float alpha = __builtin_amdgcn_exp2f(-dl);
                l *= alpha;
#pragma unroll
                for (int d0 = 0; d0 < 4; ++d0) for (int r = 0; r < 16; ++r) o[d0][r] *= alpha;
            }
        }
        float ps = 0.f;
#pragma unroll
        for (int r = 0; r < 16; ++r) { p0[r] = __builtin_amdgcn_exp2f(p0[r]); p1[r] = __builtin_amdgcn_exp2f(p1[r]); ps += p0[r] + p1[r]; }
        l += ps;
        bf16x8 pb[4];
#pragma unroll
        for (int s2 = 0; s2 < 2; ++s2) {
            u32x4 w0 = {cvtpk(p0[8 * s2], p0[8 * s2 + 1]), cvtpk(p0[8 * s2 + 2], p0[8 * s2 + 3]), cvtpk(p0[8 * s2 + 4], p0[8 * s2 + 5]), cvtpk(p0[8 * s2 + 6], p0[8 * s2 + 7])};
            u32x4 w1 = {cvtpk(p1[8 * s2], p1[8 * s2 + 1]), cvtpk(p1[8 * s2 + 2], p1[8 * s2 + 3]), cvtpk(p1[8 * s2 + 4], p1[8 * s2 + 5]), cvtpk(p1[8 * s2 + 6], p1[8 * s2 + 7])};
            pb[s2] = __builtin_bit_cast(bf16x8, w0); pb[2 + s2] = __builtin_bit_cast(bf16x8, w1);
        }
        const LAS unsigned char* vt = Vl + 256 * 64 * kt;
#pragma unroll
        for (int d0 = 0; d0 < 4; ++d0)
#pragma unroll
            for (int ks = 0; ks < 4; ++ks) {
                const LAS unsigned char* vp = vt + vb[d0] + 256 * 16 * ks;
                const s16x4 lo4 = __builtin_bit_cast(s16x4, __builtin_amdgcn_ds_read_tr16_b64_v4i16((LAS s16x4*)(vp)));
                const s16x4 hi4 = __builtin_bit_cast(s16x4, __builtin_amdgcn_ds_read_tr16_b64_v4i16((LAS s16x4*)(vp + 256 * 8)));
                const bf16x8 va = __builtin_shufflevector(lo4, hi4, 0, 1, 2, 3, 4, 5, 6, 7);
                o[d0] = __builtin_amdgcn_mfma_f32_32x32x16_bf16(va, pb[ks], o[d0], 0, 0, 0);
            }
    }
    m_out = m; l_out = l;
}

__device__ __forceinline__ void att_stage_kv(Frame& F, int h, int j, LAS unsigned char* Kl, LAS unsigned char* Vl, LAS float* lut) {
    const int tid = F.wave * 64 + hw_lane();
    const unsigned char* kg = F.KVZ8 + ((size_t)h * HSQ + j * BLK) * HD; const unsigned char* vg = kg + (size_t)NH * HSQ * HD;
    u32x4 kv[4], vv[4];
#pragma unroll
    for (int i = 0; i < 4; ++i) { const int p = tid + 512 * i, row = p >> 3, c8 = p & 7; kv[i] = *(const u32x4*)(kg + row * 128 + 16 * c8); vv[i] = *(const u32x4*)(vg + row * 128 + 16 * c8); }
    for (int i = tid; i < 768; i += 512) {
        const int dist = i - 255; float v;
        if (dist < 0) v = -INFINITY;
        else { int b; if (dist < 16) b = dist; else { b = 16 + (int)(logf((float)dist * (1.f / 16.f)) / logf(8.f) * 16.f); b = b > 31 ? 31 : b; }
               v = F.rel_bias[b * NH + h] * LOG2E; }
        lut[i] = v;
    }
#define F8TOBF(x, lo, hi_) do { const f32x2_t a_ = __builtin_amdgcn_cvt_pk_f32_fp8((int)(x), false), b_ = __builtin_amdgcn_cvt_pk_f32_fp8((int)(x), true); lo = cvtpk(a_[0], a_[1]); hi_ = cvtpk(b_[0], b_[1]); } while (0)
#pragma unroll
    for (int i = 0; i < 4; ++i) { const int p = tid + 512 * i, row = p >> 3, c8 = p & 7;
        u32x4 k0, k1, v0, v1;
        F8TOBF(kv[i].x, k0.x, k0.y); F8TOBF(kv[i].y, k0.z, k0.w); F8TOBF(kv[i].z, k1.x, k1.y); F8TOBF(kv[i].w, k1.z, k1.w);
        F8TOBF(vv[i].x, v0.x, v0.y); F8TOBF(vv[i].y, v0.z, v0.w); F8TOBF(vv[i].z, v1.x, v1.y); F8TOBF(vv[i].w, v1.z, v1.w);
        *(LAS u32x4*)(Kl + 256 * row + ((16 * (2 * c8)) ^ ((row & 15) << 4))) = k0; *(LAS u32x4*)(Kl + 256 * row + ((16 * (2 * c8 + 1)) ^ ((row & 15) << 4))) = k1;
        *(LAS u32x4*)(Vl + 256 * row + 16 * ((2 * c8) ^ ((row & 3) << 2))) = v0; *(LAS u32x4*)(Vl + 256 * row + 16 * ((2 * c8 + 1) ^ ((row & 3) << 2))) = v1; }
#undef F8TOBF
}

constexpr int TG = 16;
constexpr int ATT_TAB_OFF = RING_BYTES + 4608;
constexpr int ATT_NT_OFF = ATT_TAB_OFF + 2304;
struct TileMeta { int s, slot, dbase, valid; };
__device__ __forceinline__ void p3_fetch(Frame& F, int h, int j, int t, int n, const LAS int* pre, int r32, int hi, TileMeta& mt, bf16x8 (&q)[8]) {
    const int e0 = 32 * t + r32; mt.valid = e0 < n ? 1 : 0; const int e = mt.valid ? e0 : n - 1;
    int lo = 0, hh = 32;
#pragma unroll
    for (int it = 0; it < 5; ++it) { const int mid = (lo + hh) >> 1; if (pre[mid] <= e) lo = mid; else hh = mid; }
    const int qb = lo;
    const unsigned ent = F.LIST[(((size_t)h * NB + j) * NB + qb) * BLK + (e - pre[qb])];
    mt.s = ent & 8191; mt.slot = ent >> 13; mt.dbase = mt.s - j * BLK;
    const bf16_t* qp = F.PROJ + ((size_t)h * HSQ + mt.s) * HD + 8 * hi;
#pragma unroll
    for (int st = 0; st < 8; ++st) q[st] = *(const bf16x8*)(qp + 16 * st);
}
__device__ __forceinline__ void p3_compute_store(Frame& F, int h, const LAS unsigned char* Kl, const LAS unsigned char* Vl, const LAS float* lut, float c31,
                                                 const TileMeta& mt, const bf16x8 (&qr)[8], int r32, int hi, int lane) {
    f32x16 o[4]; float m, l;
    const int dbc = mt.dbase < 511 ? mt.dbase : 511;
    const bool general = !__all(mt.dbase >= 368);
    if (general) att_tile<true>(Kl, Vl, lut + (dbc + 255 - 4 * hi), c31, 4, qr, r32, hi, lane, m, l, o);
    else att_tile<false>(Kl, Vl, lut, c31, 4, qr, r32, hi, lane, m, l, o);
    { auto rr = __builtin_amdgcn_permlane32_swap(__float_as_uint(l), __float_as_uint(l), false, false); l = __uint_as_float(rr[0]) + __uint_as_float(rr[1]); }
    const float inv = 1.0f / l;
    if (mt.valid) {
        unsigned char* op = (unsigned char*)F.PART + (((size_t)h * HSQ + mt.s) * 4 + mt.slot) * HD + 16 * hi;
        const float sc = inv * (16.f / 8.f);
#pragma unroll
        for (int d0 = 0; d0 < 4; ++d0) { u32x4 w;
#pragma unroll
            for (int q4 = 0; q4 < 4; ++q4) { int x = __builtin_amdgcn_cvt_pk_fp8_f32(__builtin_amdgcn_fmed3f(o[d0][4 * q4] * sc, -448.f, 448.f), __builtin_amdgcn_fmed3f(o[d0][4 * q4 + 1] * sc, -448.f, 448.f), 0, false);
                x = __builtin_amdgcn_cvt_pk_fp8_f32(__builtin_amdgcn_fmed3f(o[d0][4 * q4 + 2] * sc, -448.f, 448.f), __builtin_amdgcn_fmed3f(o[d0][4 * q4 + 3] * sc, -448.f, 448.f), x, true); w[q4] = (unsigned)x; }
            *(u32x4*)(op + 32 * d0) = w; }
        if (hi == 0) F.LSE[((size_t)h * SEQ + mt.s) * 4 + mt.slot] = m + __log2f(l);
    }
}
__device__ __forceinline__ void p3a_selected(Frame& F, int cw_item) {
    const int lane = hw_lane(), tid = F.wave * 64 + lane;
    LAS unsigned char* Kl = F.lds; LAS unsigned char* Vl = F.lds + 65536;
    LAS float* lut = (LAS float*)(F.lds + ATT_LUT_OFF);
    LAS int* misc = (LAS int*)(F.lds + ATT_MISC_OFF);
    LAS int* prefix = (LAS int*)(F.lds + ATT_TAB_OFF); LAS int* ntile = (LAS int*)(F.lds + ATT_NT_OFF);
    const int r32 = lane & 31, hi = lane >> 5;
    {
        const int p = tid, h = p & 15, j = p >> 4;
        const int* c = F.CNT + ((size_t)h * NB + j) * NB; int n = 0;
#pragma unroll
        for (int q4 = 0; q4 < 8; ++q4) { const u32x4 v = *(const u32x4*)(c + 4 * q4);
            n += (4 * q4 + 0 > j ? (int)v.x : 0) + (4 * q4 + 1 > j ? (int)v.y : 0) + (4 * q4 + 2 > j ? (int)v.z : 0) + (4 * q4 + 3 > j ? (int)v.w : 0); }
        const int tiles = (n + 31) >> 5, groups = (tiles + TG - 1) / TG;
        int incl = groups;
#pragma unroll
        for (int o = 1; o < 64; o <<= 1) { const int y = __shfl_up(incl, o); if (lane >= o) incl += y; }
        if (lane == 63) misc[8 + F.wave] = incl;
        LDS_WAIT(); __syncthreads();
        int base = 0;
#pragma unroll
        for (int w2 = 0; w2 < 8; ++w2) if (w2 < F.wave) base += misc[8 + w2];
        prefix[p + 1] = base + incl; if (p == 0) prefix[0] = 0; ntile[p] = tiles;
        LDS_WAIT(); __syncthreads();
    }
    const int NITEMS = prefix[512];
    int nxt_item = 0;
    if (tid == 0) nxt_item = (int)__hip_atomic_fetch_add(F.ctl + cw_item, 1u, RLX_AGENT);
    for (;;) {
        if (tid == 0) misc[0] = nxt_item;
        LDS_WAIT(); __syncthreads();
        const int qi = __builtin_amdgcn_readfirstlane(misc[0]);
        constexpr int NCV = 256;
        const int NTOT = NITEMS + NCV;
        if (qi >= NTOT) break;
        if (tid == 0) nxt_item = (int)__hip_atomic_fetch_add(F.ctl + cw_item, 1u, RLX_AGENT);
        const int cvb = (int)(((long)qi * NCV) / NTOT), cva = (int)(((long)(qi + 1) * NCV) / NTOT);
        if (cva > cvb) {
            LAS unsigned* T = (LAS unsigned*)F.lds;
            const int lane2 = hw_lane(), tid2 = F.wave * 64 + lane2;
            f32x4 va[8], vb[8]; const int r0 = 4 * cvb;
            p0_tile_load(va, F.w_out, DM, (r0 + 0) >> 4, (r0 + 0) & 15, F.wave, lane2);
            p0_tile_load(vb, F.w_out, DM, (r0 + 1) >> 4, (r0 + 1) & 15, F.wave, lane2); p0_tile_out(va, F, F.WoutT, (r0 + 0) >> 4, (r0 + 0) & 15, T, tid2, lane2);
            p0_tile_load(va, F.w_out, DM, (r0 + 2) >> 4, (r0 + 2) & 15, F.wave, lane2); p0_tile_out(vb, F, F.WoutT, (r0 + 1) >> 4, (r0 + 1) & 15, T, tid2, lane2);
            p0_tile_load(vb, F.w_out, DM, (r0 + 3) >> 4, (r0 + 3) & 15, F.wave, lane2); p0_tile_out(va, F, F.WoutT, (r0 + 2) >> 4, (r0 + 2) & 15, T, tid2, lane2);
            p0_tile_out(vb, F, F.WoutT, (r0 + 3) >> 4, (r0 + 3) & 15, T, tid2, lane2);
            continue;
        }
        const int item = qi - cvb;
        int plo = 0, phi = 512;
#pragma unroll
        for (int it = 0; it < 9; ++it) { const int mid = (plo + phi) >> 1; if (prefix[mid] <= item) plo = mid; else phi = mid; }
        const int p = __builtin_amdgcn_readfirstlane(plo), g = item - __builtin_amdgcn_readfirstlane(prefix[plo]);
        const int h = p & 15, j = p >> 4;
        if (F.wave == 0) {
            const int ln = hw_lane();
            int v = 0; if (ln < 32 && ln > j) v = F.CNT[((size_t)h * NB + j) * NB + ln];
            int incl = v;
#pragma unroll
            for (int o = 1; o < 32; o <<= 1) { const int y = __shfl_up(incl, o); if (ln >= o) incl += y; }
            if (ln < 32) misc[17 + ln] = incl; if (ln == 0) misc[16] = 0;
        }
        att_stage_kv(F, h, j, Kl, Vl, lut);
        LDS_WAIT(); __syncthreads();
        const LAS int* pre = misc + 16;
        const int n = pre[32];
        const float c31 = F.rel_bias[31 * NH + h] * LOG2E;
        const int t_end = (g * TG + TG) < ntile[p] ? (g * TG + TG) : ntile[p];
        int t = g * TG + F.wave;
        for (; t < t_end; t += NWAVES) { TileMeta mA; bf16x8 qA[8]; p3_fetch(F, h, j, t, n, pre, r32, hi, mA, qA); p3_compute_store(F, h, Kl, Vl, lut, c31, mA, qA, r32, hi, lane); }
        __syncthreads();
    }
}

__device__ __forceinline__ void p3b_own_combine(Frame& F) {
    LAS unsigned char* Kl = F.lds; LAS unsigned char* Vl = F.lds + 65536;
    LAS float* lut = (LAS float*)(F.lds + ATT_LUT_OFF);
    for (int p = F.vcu; p < NH * NB; p += F.G) {
        const int lane = hw_lane(), r32 = lane & 31, hi = lane >> 5;
        const int h = p & 15, qb = p >> 4;
        att_stage_kv(F, h, qb, Kl, Vl, lut);
        LDS_WAIT(); __syncthreads();
        const int ql = 32 * F.wave + r32, s = qb * BLK + ql;
        bf16x8 qr[8];
        const bf16_t* qp = F.PROJ + ((size_t)h * HSQ + s) * HD + 8 * hi;
#pragma unroll
        for (int st = 0; st < 8; ++st) qr[st] = *(const bf16x8*)(qp + 16 * st);
        const f32x4 L = *(const f32x4*)(F.LSE + ((size_t)h * SEQ + s) * 4);
        f32x16 o[4]; float m, l;
        att_tile<true>(Kl, Vl, lut + (ql + 255 - 4 * hi), 0.f, (F.wave >> 1) + 1, qr, r32, hi, lane, m, l, o);
        { auto rr = __builtin_amdgcn_permlane32_swap(__float_as_uint(l), __float_as_uint(l), false, false); l = __uint_as_float(rr[0]) + __uint_as_float(rr[1]); }
        const int nv = qb < 3 ? qb : 3;
        const float lse_own = m + __log2f(l);
        float M = lse_own;
#pragma unroll
        for (int r = 0; r < 3; ++r) if (r < nv) M = fmaxf(M, L[r]);
        float w[3]; float wo = __builtin_amdgcn_exp2f(lse_own - M); float wsum = wo;
#pragma unroll
        for (int r = 0; r < 3; ++r) { w[r] = (r < nv) ? __builtin_amdgcn_exp2f(L[r] - M) : 0.f; wsum += w[r]; }
        const float iw = 1.0f / wsum; wo = wo * iw / (l * 8.f);
#pragma unroll
        for (int r = 0; r < 3; ++r) w[r] *= iw * (1.f / 16.f);
        const int lane3 = hw_lane(), hi3 = lane3 >> 5, s3 = qb * BLK + 32 * F.wave + (lane3 & 31);
        const unsigned char* pp = (const unsigned char*)F.PART + (((size_t)h * HSQ + s3) * 4) * HD + 16 * hi3;
        const unsigned char* zp = F.KVZ8 + ((size_t)(2 * NH + h) * HSQ + s3) * HD + 16 * hi3;
#pragma unroll
        for (int d0 = 0; d0 < 4; ++d0) for (int e = 0; e < 16; ++e) o[d0][e] *= wo;
        u32x4 pa[4], pb[4], zv[4];
#define P3B_LD(dst, r) do { _Pragma("unroll") for (int d0 = 0; d0 < 4; ++d0) dst[d0] = *(const u32x4*)(pp + (r) * HD + 32 * d0); } while (0)
#define P3B_USE(srcv, r) do { _Pragma("unroll") for (int d0 = 0; d0 < 4; ++d0) _Pragma("unroll") for (int q4 = 0; q4 < 4; ++q4) { const int x = (int)srcv[d0][q4]; \
            const f32x2_t lo = __builtin_amdgcn_cvt_pk_f32_fp8(x, false), hi2 = __builtin_amdgcn_cvt_pk_f32_fp8(x, true); \
            o[d0][4 * q4 + 0] += w[r] * lo[0]; o[d0][4 * q4 + 1] += w[r] * lo[1]; o[d0][4 * q4 + 2] += w[r] * hi2[0]; o[d0][4 * q4 + 3] += w[r] * hi2[1]; } } while (0)
#define P3B_LDZ() do { _Pragma("unroll") for (int d0 = 0; d0 < 4; ++d0) zv[d0] = *(const u32x4*)(zp + 32 * d0); } while (0)
        asm volatile("" ::: "memory");
        if (nv == 3) { P3B_LD(pa, 0); P3B_LD(pb, 1); asm volatile("" ::: "memory"); P3B_USE(pa, 0); P3B_LD(pa, 2); asm volatile("" ::: "memory"); P3B_USE(pb, 1); P3B_LDZ(); asm volatile("" ::: "memory"); P3B_USE(pa, 2); }
        else if (nv == 2) { P3B_LD(pa, 0); P3B_LD(pb, 1); asm volatile("" ::: "memory"); P3B_USE(pa, 0); P3B_LDZ(); asm volatile("" ::: "memory"); P3B_USE(pb, 1); }
        else if (nv == 1) { P3B_LD(pa, 0); P3B_LDZ(); asm volatile("" ::: "memory"); P3B_USE(pa, 0); }
        else { P3B_LDZ(); }
#undef P3B_LD
#undef P3B_USE
#undef P3B_LDZ
        {
            unsigned char* mp8 = (unsigned char*)F.MIX + (size_t)s * (2 * DM) + h * HD + 16 * hi;
#define MIX8(v, zz) __builtin_amdgcn_fmed3f((v) * silu_f((zz) * 0.125f) * 16.f, -448.f, 448.f)
#pragma unroll
            for (int d0 = 0; d0 < 4; ++d0) { u32x4 ov;
#pragma unroll
                for (int q4 = 0; q4 < 4; ++q4) { const int zx = (int)zv[d0][q4]; const f32x2_t zl = __builtin_amdgcn_cvt_pk_f32_fp8(zx, false), zh = __builtin_amdgcn_cvt_pk_f32_fp8(zx, true);
                    int w0 = __builtin_amdgcn_cvt_pk_fp8_f32(MIX8(o[d0][4 * q4], zl[0]), MIX8(o[d0][4 * q4 + 1], zl[1]), 0, false);
                    w0 = __builtin_amdgcn_cvt_pk_fp8_f32(MIX8(o[d0][4 * q4 + 2], zh[0]), MIX8(o[d0][4 * q4 + 3], zh[1]), w0, true); ov[q4] = (unsigned)w0; }
                *(u32x4*)(mp8 + 32 * d0) = ov; }
#undef MIX8
        }
        __syncthreads();
    }
}

__device__ __forceinline__ void p4_mix(Frame& F) {
    const int lane = hw_lane(), tid = F.wave * 64 + lane;
    const int gt = F.vcu * 512 + tid, NT = F.G * 512;
    for (int idx = gt; idx < 128 * 2 * 512; idx += NT) {
        const int ch = 4 * (idx & 511), rr = (idx >> 9) & 1, st = idx >> 10;
        const float* bz = F.BZT + (((size_t)st * 2 + rr) * 3) * 2048 + ch;
        const f32x4 bg = *(const f32x4*)bz, z = *(const f32x4*)(bz + 2048), t0 = *(const f32x4*)(bz + 4096);
        const f32x4 zero = {0.f, 0.f, 0.f, 0.f};
        const f32x4 p63 = st ? *(const f32x4*)(F.TH + ((size_t)(st - 1) * 2 + 1) * 2048 + ch) : zero;
        const f32x4 p62 = st ? *(const f32x4*)(F.TH + ((size_t)(st - 1) * 2 + 0) * 2048 + ch) : zero;
        const f32x4 own0 = *(const f32x4*)(F.BZT + (((size_t)st * 2 + 0) * 3 + 2) * 2048 + ch);
        const f32x4 t1 = rr ? own0 : p63, t2 = rr ? p63 : p62;
        const f32x4 w0 = *(const f32x4*)(F.conv_w + ch), w1 = *(const f32x4*)(F.conv_w + 2048 + ch), w2 = *(const f32x4*)(F.conv_w + 4096 + ch);
        const f32x4 y = w0 * t2 + w1 * t1 + w2 * t0;
        u32x2 o; o.x = cvtpk(bg[0] * y[0] * silu_f(z[0]), bg[1] * y[1] * silu_f(z[1])); o.y = cvtpk(bg[2] * y[2] * silu_f(z[2]), bg[3] * y[3] * silu_f(z[3]));
        *(u32x2*)(F.MIX + (size_t)(st * 64 + rr) * DM + AW + ch) = o;
    }
}

__device__ __forceinline__ void p6_final(Frame& F) {
    const int lane = hw_lane(), tid = F.wave * 64 + lane;
    const int gw = F.vcu * NWAVES + F.wave, NGW = F.G * NWAVES;
    for (int row = gw; row < SEQ; row += NGW) {
        const float ss = wave_sum(F.ROWSS[(size_t)row * 64 + lane]);
        const float rstd = 1.0f / sqrtf(ss * (1.f / DM) + EPS);
        f32x4* orow = (f32x4*)(F.out + (size_t)row * DM) + lane; const f32x4* gr = (const f32x4*)F.fg + lane;
        f32x4 v[16];
#pragma unroll
        for (int j = 0; j < 16; ++j) v[j] = orow[64 * j];
#pragma unroll
        for (int j = 0; j < 16; ++j) { const f32x4 g = gr[64 * j]; f32x4 r; r[0] = v[j][0] * rstd * g[0]; r[1] = v[j][1] * rstd * g[1]; r[2] = v[j][2] * rstd * g[2]; r[3] = v[j][3] * rstd * g[3]; orow[64 * j] = r; }
    }
}

struct Args { const float* x; const float* ng; const float* w_in; const float* conv_w; const float* w_out; const float* rel_bias; const float* fg; float* out; unsigned char* ws; int ph_lo, ph_hi; };
__global__ void __launch_bounds__(NWAVES * 64, 2) mk_fwd(Args args) {
    extern __shared__ __attribute__((aligned(16))) unsigned char lds[];
    Frame F;
    F.lds = (LAS unsigned char*)lds;
    F.MISC = (volatile LAS unsigned*)(F.lds + MISC_OFF);
    F.wave = __builtin_amdgcn_readfirstlane((int)(threadIdx.x >> 6));
    F.G = gridDim.x; { const int bx = blockIdx.x; F.vcu = (F.G % 8 == 0) ? (bx % 8) * (F.G / 8) + bx / 8 : bx; }
    unsigned char* ws = args.ws;
    F.ctl = (unsigned*)(ws + WS_CTL);
    F.x = args.x; F.ng = args.ng; F.w_in = args.w_in; F.conv_w = args.conv_w; F.w_out = args.w_out; F.rel_bias = args.rel_bias; F.fg = args.fg; F.out = args.out;
    F.WinT = (bf16_t*)(ws + WS_WIN); F.WoutT = (bf16_t*)(ws + WS_WOUT); F.U = (bf16_t*)(ws + WS_U); F.PROJ = (bf16_t*)(ws + WS_PROJ); F.MIX = (bf16_t*)(ws + WS_MIX); F.PART = (bf16_t*)(ws + WS_PART);
    F.W8 = ws + WS_W8; F.U8 = ws + WS_U8; F.KVZ8 = ws + WS_KVZ8; F.TH = (float*)(ws + WS_TH); F.BZT = (float*)(ws + WS_BZT);
    F.LSE = (float*)(ws + WS_LSE); F.KSUM = (float*)(ws + WS_KSUM); F.ROWSS = (float*)(ws + WS_ROWSS); F.RSTD = (float*)(ws + WS_RSTD); F.LIST = (unsigned short*)(ws + WS_LIST); F.CNT = (int*)(ws + WS_CNT);
    for (int u = threadIdx.x; u < (LDS_BYTES - LDSCTL_OFF) / 4; u += NWAVES * 64) ((LAS unsigned*)(F.lds + LDSCTL_OFF))[u] = 0u;
    __syncthreads();
    XcdBarrier bar; bar.bar = F.ctl + CW_BAR; bar.x = 0; bar.st = nullptr;
    if (N_LAUNCHES == 1) bar = xcd_barrier_post(F.ctl + CW_BAR, F.MISC + 8);
#define GRID_BAR() do { if (N_LAUNCHES == 1) xcd_barrier(bar); } while (0)
    const int lo = args.ph_lo, hi = args.ph_hi;
#define IN(k) (lo <= (k) && (k) < hi)
#define BOTH(k) (IN(k) && IN((k) + 1))
    if (IN(0)) { p0_prologue(F); if (BOTH(0)) GRID_BAR(); }
    if (IN(1)) {
        {
            pg8::Gemm g{F.U, F.WinT + (size_t)8192 * DM, SEQ, 8192, 8192, 64}; pg8::StaticOrder S; S.init(SEQ, 8192, F.G, (int)blockIdx.x);
            pg8::EpiConv E{F.MIX, F.conv_w, F.TH, F.BZT, F.RSTD};
            pg8::gemm_phase<pg8::EpiConv, pg8::StaticOrder, true, true, false>(F.lds, g, S, E, F.wave);
        }
        {
            pg8::Gemm g{F.U8, F.W8, SEQ, 8192, 4096, 32}; pg8::StaticOrder S; S.init(SEQ, 8192, F.G, (int)blockIdx.x);
            pg8::EpiProj E{F.PROJ, AW, F.KSUM, F.KVZ8};
            pg8::gemm_phase<pg8::EpiProj, pg8::StaticOrder, true, true, true>(F.lds, g, S, E, F.wave);
        }
        if (BOTH(1)) GRID_BAR();
    }
    if (IN(2)) { p2_route(F); if (BOTH(2)) GRID_BAR(); }
    if (IN(3)) { p3a_selected(F, CW_ITEM); if (BOTH(3)) GRID_BAR(); }
    if (IN(4)) { p3b_own_combine(F); p4_mix(F); if (BOTH(4)) GRID_BAR(); }
    if (IN(5)) {
        pg8::Gemm g{F.MIX, F.WoutT, SEQ, DM, 8192, 52, F.U};
        pg8::Gemm g48{F.MIX, F.WoutT, SEQ, DM, 8192, 48};
        pg8::StaticOrder S; S.init(SEQ, DM, F.G, (int)blockIdx.x);
        pg8::Unit u0, u1; const bool two = S.next(0, u0) && S.next(1, u1) && !S.next(2, u1) && S.next(1, u1) && u0.pm == u1.pm;
        if (F.G == 256) {
            const int c = (int)blockIdx.x, xcd = c & 7, off = c >> 3;
            for (int r = 0; r < 2; ++r) {
                pg8::OneUnit S1; S1.u.pm = 8 * (xcd >> 1) + 4 * r + (off & 3); S1.u.pn = 8 * (xcd & 1) + (off >> 2);
                pg8::EpiOutNorm E{F.U, F.out, F.ROWSS, F.fg, F.ctl + CW_PANEL, F.ctl + CW_TMO, -1, F.PART, 16u, true};
                pg8::gemm_phase<pg8::EpiOutNorm, pg8::OneUnit, true, true, false, 16, 4>(F.lds, g, S1, E, F.wave);
                __syncthreads();
            }
        } else if (two) {
            pg8::EpiOutNorm E{F.U, F.out, F.ROWSS, F.fg, F.ctl + CW_PANEL, F.ctl + CW_TMO, u0.pn, F.PART, 8u, false};
            pg8::gemm_phase<pg8::EpiOutNorm, pg8::StaticOrder, true, true, false, 16>(F.lds, g48, S, E, F.wave);
        } else {
            pg8::EpiOut E{F.x, F.out, F.ROWSS};
            pg8::gemm_phase<pg8::EpiOut, pg8::StaticOrder, true, true, false, 16>(F.lds, g48, S, E, F.wave);
            GRID_BAR(); p6_final(F);
        }
    }
#undef IN
#undef BOTH
}

extern "C" void kernel_launch(void* const* d_in, const int* in_sizes, int n_in, void* d_out, int out_size, void* d_ws, size_t ws_size, hipStream_t stream) {
    static int grid = 0;
    if (grid == 0) {
        if (n_in != 7 || in_sizes[0] != SEQ * DM || out_size != SEQ * DM || ws_size < WS_END) {
            fprintf(stderr, "kernel_launch: unexpected shapes (n_in %d, in0 %d, out %d, ws %zu); nothing launched\n", n_in, n_in > 0 ? in_sizes[0] : -1, out_size, ws_size); grid = -1; return; }
        int dev = 0, cus = 0, per_cu = 0;
        if (hipGetDevice(&dev) != hipSuccess || hipDeviceGetAttribute(&cus, hipDeviceAttributeMultiprocessorCount, dev) != hipSuccess) { fprintf(stderr, "kernel_launch: device query failed\n"); grid = -1; return; }
        if (hipFuncSetAttribute((const void*)mk_fwd, hipFuncAttributeMaxDynamicSharedMemorySize, LDS_BYTES) != hipSuccess) { fprintf(stderr, "kernel_launch: hipFuncSetAttribute failed\n"); grid = -1; return; }
        if (hipOccupancyMaxActiveBlocksPerMultiprocessor(&per_cu, (const void*)mk_fwd, NWAVES * 64, LDS_BYTES) != hipSuccess || per_cu < 1) {
            fprintf(stderr, "kernel_launch: occupancy query reports %d workgroups per CU\n", per_cu); (void)hipGetLastError(); grid = -1; return; }
        grid = cus;
    }
    if (grid < 0) return;
    (void)hipMemsetAsync((char*)d_ws + WS_CTL, 0, CTL_ZERO_BYTES, stream);
    Args a{};
    a.x = (const float*)d_in[0]; a.ng = (const float*)d_in[1]; a.w_in = (const float*)d_in[2]; a.conv_w = (const float*)d_in[3]; a.w_out = (const float*)d_in[4];
    a.rel_bias = (const float*)d_in[5]; a.fg = (const float*)d_in[6]; a.out = (float*)d_out; a.ws = (unsigned char*)d_ws;
    if (N_LAUNCHES == 1) { a.ph_lo = 0; a.ph_hi = N_PHASES; hipLaunchKernelGGL(mk_fwd, dim3(grid), dim3(NWAVES * 64), LDS_BYTES, stream, a); }
    else { for (int p = 0; p < N_PHASES; ++p) { a.ph_lo = p; a.ph_hi = p + 1; hipLaunchKernelGGL(mk_fwd, dim3(grid), dim3(NWAVES * 64), LDS_BYTES, stream, a); } }
}
```
